# Optimizing an MI355X kernel written in HIP

```python
import math
import jax
import jax.numpy as jnp
from jax import lax
import numpy as np

D_MODEL = 1024
BATCH = 4
SEQ = 8192
DEPTH = 2
DEC_BATCH = 32
DEC_SEQ = 32
PAST_LEN = 1024

CHUNK = 64
N_PAST_CHUNKS = 8
ATT_HEADS = 8
ATT_HEAD_DIM = 64
ATT_WIDTH = ATT_HEADS * ATT_HEAD_DIM
MAX_REL = 256
REL_SIZE = MAX_REL + CHUNK
M_HEADS = 4
M_HEAD_DIM = 128
M_WIDTH = M_HEADS * M_HEAD_DIM
CONV_W = 4
D_FF = -(-8 * D_MODEL // (3 * 256)) * 256
IN_WIDTH = 3 * ATT_WIDTH + 4 * M_WIDTH + 2 * M_HEADS + 2 * D_MODEL
EPS = 1e-6
NEG = -1e30

kernel_name = 'hybrid_stream_bandattn_mlstm_step'


def _split_points():
    widths = [ATT_WIDTH] * 3 + [M_WIDTH] * 4 + [M_HEADS] * 2 + [D_MODEL] * 2
    return [int(p) for p in np.cumsum(widths)[:-1]]


def rmsnorm(x, g):
    xf = x.astype(jnp.float32)
    y = xf * lax.rsqrt(jnp.mean(xf * xf, axis=-1, keepdims=True) + EPS)
    return (y * g.astype(jnp.float32)).astype(x.dtype)


def head_rmsnorm(h, gain):
    B, T = h.shape[0], h.shape[1]
    y = h * lax.rsqrt(jnp.mean(h * h, axis=-1, keepdims=True) + EPS)
    return y.reshape(B, T, M_WIDTH) * gain.astype(jnp.float32)


def rel_bias_block(rel_bias, n_q, n_k, n_past):
    dist = jnp.arange(n_q)[:, None] + n_past - jnp.arange(n_k)[None, :]
    idx = jnp.clip(dist, -(CHUNK - 1), MAX_REL) + (CHUNK - 1)
    return rel_bias[:, idx]


def band_core(q, k, v, valid, bias):
    s = jnp.einsum('nqhd,nkhd->nhqk', q, k).astype(jnp.float32) * (ATT_HEAD_DIM ** -0.5)
    s = s + bias[None].astype(jnp.float32)
    s = jnp.where(valid[:, None, None, :], s, NEG)
    p = jax.nn.softmax(s, axis=-1).astype(v.dtype)
    return jnp.einsum('nhqk,nkhd->nqhd', p, v)


def prompt_band_attention(q, k, v, rel_bias):
    B, S, H, Dh = q.shape
    nc = S // CHUNK
    P = N_PAST_CHUNKS * CHUNK
    L = P + CHUNK
    idx = jnp.arange(nc)[:, None] * CHUNK + jnp.arange(L)[None, :]
    valid = idx >= P
    bias = rel_bias_block(rel_bias, CHUNK, L, P)

    def one(args):
        qs, ks, vs = args
        kp = jnp.pad(ks, ((P, 0), (0, 0), (0, 0)))[idx]
        vp = jnp.pad(vs, ((P, 0), (0, 0), (0, 0)))[idx]
        out = band_core(qs.reshape(nc, CHUNK, H, Dh), kp, vp, valid, bias)
        return out.reshape(S, H, Dh)

    return lax.map(one, (q, k, v))


def sample_band_attention(q, k, v, k_cache, v_cache, rel_bias):
    T = q.shape[1]
    pc = k_cache.shape[1]
    kb = jnp.concatenate([k_cache.astype(k.dtype), k], axis=1)[:, None]
    vb = jnp.concatenate([v_cache.astype(v.dtype), v], axis=1)[:, None]
    valid = jnp.ones((1, pc + T), dtype=bool)
    bias = rel_bias_block(rel_bias, T, pc + T, pc)
    out = jax.vmap(band_core, in_axes=(0, 0, 0, None, None))(q[:, None], kb, vb, valid, bias)
    return out[:, 0]


def mlstm_chunkwise(q, k, v, log_i, log_f, C0, n0, m0, block):
    B, T, H, Dk = q.shape
    Dv = v.shape[-1]
    nb = T // block

    def blocks(t):
        return t.astype(jnp.float32).reshape(B, nb, block, H, -1).transpose(1, 0, 3, 2, 4)

    def gblocks(t):
        return t.reshape(B, nb, block, H).transpose(1, 0, 3, 2)

    tril = jnp.tril(jnp.ones((block, block), dtype=bool))

    def step(carry, xs):
        C, n, m = carry
        qc, kc, vc, li, lf = xs
        b = jnp.cumsum(lf, axis=-1)
        a = b + m[..., None]
        D = b[..., :, None] - b[..., None, :] + li[..., None, :]
        D = jnp.where(tril, D, NEG)
        m_t = jnp.maximum(a, jnp.max(D, axis=-1))
        w_inter = jnp.exp(a - m_t)
        W = jnp.exp(D - m_t[..., None])
        S = jnp.einsum('bhtd,bhsd->bhts', qc, kc) * W
        num = jnp.einsum('bhts,bhsv->bhtv', S, vc) + w_inter[..., None] * jnp.einsum('bhtd,bhdv->bhtv', qc, C)
        den = jnp.sum(S, axis=-1) + w_inter * jnp.einsum('bhtd,bhd->bht', qc, n)
        h = num / jnp.maximum(jnp.abs(den), jnp.exp(-m_t))[..., None]
        m_new = m_t[..., -1]
        g_state = jnp.exp(b[..., -1] + m - m_new)
        w_s = jnp.exp(b[..., -1:] - b + li - m_new[..., None])
        C_new = g_state[..., None, None] * C + jnp.einsum('bhs,bhsd,bhsv->bhdv', w_s, kc, vc)
        n_new = g_state[..., None] * n + jnp.einsum('bhs,bhsd->bhd', w_s, kc)
        return (C_new, n_new, m_new), h

    carry0 = (C0.astype(jnp.float32), n0.astype(jnp.float32), m0.astype(jnp.float32))
    xs = (blocks(q), blocks(k), blocks(v), gblocks(log_i), gblocks(log_f))
    (C1, n1, m1), hs = lax.scan(step, carry0, xs)
    h = hs.transpose(1, 0, 3, 2, 4).reshape(B, T, H, Dv)
    return h, (C1, n1, m1)


def trunk_layer(x, c, k_cache, v_cache, conv_left, C0, n0, m0,
                w_ada, b_ada, g_mix, w_in, b_if, conv_w, conv_b, rel_bias, mh_gain,
                w_br_att, w_br_mlstm, w_out, g_ffn, w_gate_up, w_down):
    B, T, _ = x.shape
    dt = x.dtype
    mod = jax.nn.silu(c) @ w_ada + b_ada
    sh1, sc1, gt1, sh2, sc2, gt2 = jnp.split(mod[:, None, :], 6, axis=-1)

    h = rmsnorm(x, g_mix) * (1 + sc1) + sh1
    u = h @ w_in
    qa, ka, va, qm, km, vm, om, ip, fp, ga, gm = jnp.split(u, _split_points(), axis=-1)

    qa = qa.reshape(B, T, ATT_HEADS, ATT_HEAD_DIM)
    ka = ka.reshape(B, T, ATT_HEADS, ATT_HEAD_DIM)
    va = va.reshape(B, T, ATT_HEADS, ATT_HEAD_DIM)
    if k_cache is None:
        ya = prompt_band_attention(qa, ka, va, rel_bias)
        keep = min(N_PAST_CHUNKS * CHUNK, T)
        new_k, new_v = ka[:, T - keep:], va[:, T - keep:]
    else:
        ya = sample_band_attention(qa, ka, va, k_cache, v_cache, rel_bias)
        new_k, new_v = ka, va

    qk_in = jnp.concatenate([qm, km], axis=-1)
    xpad = jnp.concatenate([conv_left.astype(dt), qk_in], axis=1)
    conv = sum(xpad[:, j:j + T] * conv_w[j] for j in range(CONV_W)) + conv_b
    new_conv = xpad[:, -(CONV_W - 1):]
    conv = jax.nn.silu(conv)
    q_m, k_m = jnp.split(conv, 2, axis=-1)
    q_m = q_m.reshape(B, T, M_HEADS, M_HEAD_DIM)
    k_m = k_m.reshape(B, T, M_HEADS, M_HEAD_DIM) * (M_HEAD_DIM ** -0.5)
    v_m = vm.reshape(B, T, M_HEADS, M_HEAD_DIM)
    log_i = (ip + b_if[:M_HEADS]).astype(jnp.float32)
    log_f = jax.nn.log_sigmoid((fp + b_if[M_HEADS:]).astype(jnp.float32))
    block = CHUNK if T % CHUNK == 0 else T
    hm, (C1, n1, m1) = mlstm_chunkwise(q_m, k_m, v_m, log_i, log_f, C0, n0, m0, block)
    ym = (head_rmsnorm(hm, mh_gain) * jax.nn.sigmoid(om.astype(jnp.float32))).astype(dt)

    merged = (jax.nn.sigmoid(ga) * (ya.reshape(B, T, ATT_WIDTH) @ w_br_att)
              + jax.nn.sigmoid(gm) * (ym @ w_br_mlstm))
    x = x + gt1 * (merged @ w_out)

    h2 = rmsnorm(x, g_ffn) * (1 + sc2) + sh2
    g, up = jnp.split(h2 @ w_gate_up, 2, axis=-1)
    x = x + gt2 * ((jax.nn.silu(g) * up) @ w_down)
    return x, (new_k, new_v, new_conv, C1.astype(dt), n1.astype(dt), m1.astype(dt))


def setup_inputs(seed: int = 0) -> dict:
    key = jax.random.key(seed)
    ks = jax.random.split(key, 32)
    f32 = jnp.float32
    D = D_MODEL

    def nrm(k, shape, scale):
        return jax.random.normal(k, shape, f32) * scale

    pc = min(N_PAST_CHUNKS * CHUNK, PAST_LEN)
    b_if = jnp.concatenate([
        nrm(ks[14], (DEPTH, M_HEADS), 0.1),
        jnp.linspace(3.0, 6.0, M_HEADS, dtype=f32)[None, :] + nrm(ks[15], (DEPTH, M_HEADS), 0.1),
    ], axis=-1)
    return {
        'x_prompt': nrm(ks[0], (BATCH, SEQ, D), 1.0),
        'x_sample': nrm(ks[1], (DEC_BATCH, DEC_SEQ, D), 1.0),
        'cache_k': nrm(ks[2], (DEPTH, DEC_BATCH, pc, ATT_HEADS, ATT_HEAD_DIM), 1.0),
        'cache_v': nrm(ks[3], (DEPTH, DEC_BATCH, pc, ATT_HEADS, ATT_HEAD_DIM), 1.0),
        'state_conv': nrm(ks[4], (DEPTH, DEC_BATCH, CONV_W - 1, 2 * M_WIDTH), 1.0),
        'state_C': nrm(ks[5], (DEPTH, DEC_BATCH, M_HEADS, M_HEAD_DIM, M_HEAD_DIM), 1.0),
        'state_n': nrm(ks[6], (DEPTH, DEC_BATCH, M_HEADS, M_HEAD_DIM), 1.0),
        'state_m': nrm(ks[7], (DEPTH, DEC_BATCH, M_HEADS), 1.0),
        'c_prompt': nrm(ks[8], (BATCH, D), 1.0),
        'c_sample': nrm(ks[9], (DEC_BATCH, D), 1.0),
        'w_ada': nrm(ks[10], (DEPTH, D, 6 * D), 0.5 * D ** -0.5),
        'b_ada': nrm(ks[11], (DEPTH, 6 * D), 0.02),
        'g_mix': 1.0 + nrm(ks[12], (DEPTH, D), 0.02),
        'w_in': nrm(ks[13], (DEPTH, D, IN_WIDTH), D ** -0.5),
        'b_if': b_if,
        'conv_w': nrm(ks[16], (DEPTH, CONV_W, 2 * M_WIDTH), CONV_W ** -0.5),
        'conv_b': nrm(ks[17], (DEPTH, 2 * M_WIDTH), 0.02),
        'rel_bias': nrm(ks[18], (DEPTH, ATT_HEADS, REL_SIZE), 0.5),
        'mh_gain': 1.0 + nrm(ks[19], (DEPTH, M_WIDTH), 0.02),
        'w_br_att': nrm(ks[20], (DEPTH, ATT_WIDTH, D), ATT_WIDTH ** -0.5),
        'w_br_mlstm': nrm(ks[21], (DEPTH, M_WIDTH, D), M_WIDTH ** -0.5),
        'w_out': nrm(ks[22], (DEPTH, D, D), D ** -0.5),
        'g_ffn': 1.0 + nrm(ks[23], (DEPTH, D), 0.02),
        'w_gate_up': nrm(ks[24], (DEPTH, D, 2 * D_FF), D ** -0.5),
        'w_down': nrm(ks[25], (DEPTH, D_FF, D), D_FF ** -0.5),
        'g_final': 1.0 + nrm(ks[26], (D,), 0.02),
    }


def reference(x_prompt, x_sample, cache_k, cache_v, state_conv, state_C, state_n, state_m,
              c_prompt, c_sample, w_ada, b_ada, g_mix, w_in, b_if, conv_w, conv_b, rel_bias,
              mh_gain, w_br_att, w_br_mlstm, w_out, g_ffn, w_gate_up, w_down, g_final):
    bp = x_prompt.shape[0]
    xp, xs = x_prompt, x_sample
    outs_p, outs_s = [], []
    for l in range(DEPTH):
        wl = (w_ada[l], b_ada[l], g_mix[l], w_in[l], b_if[l], conv_w[l], conv_b[l], rel_bias[l],
              mh_gain[l], w_br_att[l], w_br_mlstm[l], w_out[l], g_ffn[l], w_gate_up[l], w_down[l])
        zc = jnp.zeros((bp, CONV_W - 1, 2 * M_WIDTH), xp.dtype)
        zC = jnp.zeros((bp, M_HEADS, M_HEAD_DIM, M_HEAD_DIM), jnp.float32)
        zn = jnp.zeros((bp, M_HEADS, M_HEAD_DIM), jnp.float32)
        zm = jnp.zeros((bp, M_HEADS), jnp.float32)
        xp, st_p = trunk_layer(xp, c_prompt, None, None, zc, zC, zn, zm, *wl)
        xs, st_s = trunk_layer(xs, c_sample, cache_k[l], cache_v[l], state_conv[l],
                               state_C[l], state_n[l], state_m[l], *wl)
        outs_p.append(st_p)
        outs_s.append(st_s)
    y_prompt = rmsnorm(xp, g_final)
    y_sample = rmsnorm(xs, g_final)

    def stk(outs, i):
        return jnp.stack([o[i] for o in outs], axis=0)

    return (y_prompt, y_sample,
            stk(outs_p, 0), stk(outs_p, 1), stk(outs_p, 2), stk(outs_p, 3), stk(outs_p, 4), stk(outs_p, 5),
            stk(outs_s, 0), stk(outs_s, 1), stk(outs_s, 2), stk(outs_s, 3), stk(outs_s, 4), stk(outs_s, 5))
```

```cpp
#include <hip/hip_runtime.h>
#include <hip/hip_cooperative_groups.h>
#include <cstdio>
#include <cstdint>
namespace cg = cooperative_groups;
#ifndef REP_GEMM
#define REP_GEMM 1
#endif
#ifndef REP_SYNC
#define REP_SYNC 0
#endif
#ifndef REP_P3
#define REP_P3 1
#endif
#ifndef REP_MOUT
#define REP_MOUT 1
#endif
#ifndef REP_SCAN
#define REP_SCAN 1
#endif
#ifndef REP_N1024
#define REP_N1024 1
#endif
#ifndef REP_COPY
#define REP_COPY 1
#endif
#ifndef REP_MISC
#define REP_MISC 1
#endif

#define LAS __attribute__((address_space(3)))
typedef unsigned short bf16;
typedef short s16x8 __attribute__((ext_vector_type(8)));
typedef float f32x4 __attribute__((ext_vector_type(4)));
typedef float f32x16 __attribute__((ext_vector_type(16)));
typedef unsigned u32x4 __attribute__((ext_vector_type(4)));
typedef unsigned u32x2 __attribute__((ext_vector_type(2)));
typedef float f32x2_t __attribute__((ext_vector_type(2)));
typedef __bf16 bf16x2_t __attribute__((ext_vector_type(2)));

constexpr int DM = 1024, MP = 32768, MS = 1024, MT = MP + MS, SEQ = 8192, NBP = 4, NBD = 32, TS = 32, NCB = 36;
constexpr int UW = 4608;
constexpr int C_QA = 0, C_KA = 512, C_QM = 1024, C_KM = 1536, C_OM = 2048, C_GA = 2560, C_GM = 3584;
constexpr int R_VA = 0, R_VM = 512, R_KM = 1024, KVR = 1536;
constexpr int DFF = 2816, INW = 5640, NWIN = UW + 1024;
constexpr float EPS = 1e-6f, LOG2E = 1.44269504089f;
constexpr int NPC = 128;
constexpr int NSLOT_P = NBP * NPC * 4, NSLOT_S = NBD * 4;

constexpr size_t O_Y = 0;
constexpr size_t O_NKP = (size_t)MT * DM;
constexpr size_t O_NVP = O_NKP + 2ull * 4 * 512 * 512;
constexpr size_t O_NCVP = O_NVP + 2ull * 4 * 512 * 512;
constexpr size_t O_NCP = O_NCVP + 2ull * 4 * 3 * 1024;
constexpr size_t O_NNP = O_NCP + 2ull * 4 * 4 * 16384;
constexpr size_t O_NMP = O_NNP + 2ull * 4 * 4 * 128;
constexpr size_t O_NKS = O_NMP + 2ull * 4 * 4;
constexpr size_t O_NVS = O_NKS + 2ull * 32 * 32 * 512;
constexpr size_t O_NCVS = O_NVS + 2ull * 32 * 32 * 512;
constexpr size_t O_NCS = O_NCVS + 2ull * 32 * 3 * 1024;
constexpr size_t O_NNS = O_NCS + 2ull * 32 * 4 * 16384;
constexpr size_t O_NMS = O_NNS + 2ull * 32 * 4 * 128;
constexpr size_t O_END = O_NMS + 2ull * 32 * 4;
static_assert(O_END == 45871392ull, "output size");

constexpr size_t al4k(size_t x) { return (x + 4095) & ~(size_t)4095; }
constexpr size_t WS_U = 0;
constexpr size_t WS_KVT = al4k(WS_U + (size_t)MT * UW * 2);
constexpr size_t WS_XN = al4k(WS_KVT + (size_t)KVR * MT * 2);
constexpr size_t WS_W = al4k(WS_XN + (size_t)MT * DM * 2);
constexpr size_t W_IN = 0, W_BA = W_IN + (size_t)NWIN * 1024 * 2, W_BM = W_BA + 1024 * 512 * 2, W_OUT = W_BM + 1024 * 512 * 2,
                 W_GU = W_OUT + 1024 * 1024 * 2, W_DN = W_GU + (size_t)2 * DFF * 1024 * 2, W_END = W_DN + (size_t)1024 * DFF * 2;
constexpr size_t WS_MODP = al4k(WS_W + W_END);
constexpr size_t WS_MOD = al4k(WS_MODP + 8ull * NCB * 6144 * 4);
constexpr size_t WS_GATES = al4k(WS_MOD + (size_t)NCB * 6144 * 4);
constexpr size_t WS_DN = al4k(WS_GATES + (size_t)MT * 8 * 4);
constexpr size_t WS_MB = al4k(WS_DN + (size_t)(NSLOT_P + NSLOT_S) * 128 * 4);
constexpr size_t WS_DCS = al4k(WS_MB + (size_t)(NSLOT_P + NSLOT_S) * 4 * 3);
constexpr size_t WS_END = al4k(WS_DCS + (size_t)NSLOT_S * 16384 * 2);
constexpr size_t WS_CTL = WS_END, CTL_BYTES = 16384;
static_assert(WS_CTL + CTL_BYTES <= 512ull * 1024 * 1024, "workspace map exceeds 512 MiB");
static_assert((size_t)NSLOT_P * 16384 * 2 <= (size_t)MT * DM * 2, "dC overlay fits in XN");

__device__ __forceinline__ unsigned pk2(float lo, float hi) { f32x2_t v = {lo, hi}; bf16x2_t b = __builtin_convertvector(v, bf16x2_t); return __builtin_bit_cast(unsigned, b); }
__device__ __forceinline__ float bflo(unsigned w) { return __uint_as_float(w << 16); }
__device__ __forceinline__ float bfhi(unsigned w) { return __uint_as_float(w & 0xffff0000u); }
__device__ __forceinline__ float bf1(bf16 h) { return __uint_as_float((unsigned)h << 16); }
__device__ __forceinline__ bf16 f2bf(float f) { return (bf16)(pk2(f, 0.f) & 0xffffu); }
__device__ __forceinline__ float fexp(float x) { return __builtin_amdgcn_exp2f(x * LOG2E); }
__device__ __forceinline__ float sigmoidf_(float x) { return __builtin_amdgcn_rcpf(1.f + fexp(-x)); }
__device__ __forceinline__ float siluf_(float x) { return x * __builtin_amdgcn_rcpf(1.f + fexp(-x)); }
__device__ __forceinline__ float wave_sum(float v) {
#pragma unroll
    for (int o = 1; o < 64; o <<= 1) v += __shfl_xor(v, o);
    return v;
}
__device__ __forceinline__ float wave_max(float v) {
#pragma unroll
    for (int o = 1; o < 64; o <<= 1) v = fmaxf(v, __shfl_xor(v, o));
    return v;
}
__device__ __forceinline__ float scan_add(float x, int lane) {
#pragma unroll
    for (int o = 1; o < 64; o <<= 1) { float v = __shfl_up(x, o); if (lane >= o) x += v; }
    return x;
}
__device__ __forceinline__ float scan_max(float x, int lane) {
#pragma unroll
    for (int o = 1; o < 64; o <<= 1) { float v = __shfl_up(x, o); if (lane >= o) x = fmaxf(x, v); }
    return x;
}
#define LDS_WAIT() asm volatile("s_waitcnt lgkmcnt(0)" ::: "memory")
#define MFMA32(a, b, c) __builtin_amdgcn_mfma_f32_32x32x16_bf16((a), (b), (c), 0, 0, 0)
__device__ __forceinline__ s16x8 pack8(const float (&x)[8]) { u32x4 p; p.x = pk2(x[0], x[1]); p.y = pk2(x[2], x[3]); p.z = pk2(x[4], x[5]); p.w = pk2(x[6], x[7]); return __builtin_bit_cast(s16x8, p); }
__device__ __forceinline__ void unpack8(u32x4 v, float (&x)[8]) { x[0] = bflo(v.x); x[1] = bfhi(v.x); x[2] = bflo(v.y); x[3] = bfhi(v.y); x[4] = bflo(v.z); x[5] = bfhi(v.z); x[6] = bflo(v.w); x[7] = bfhi(v.w); }

namespace pg8 {
typedef unsigned short bf16_t;
typedef short bf16x8 __attribute__((ext_vector_type(8)));
constexpr int BM = 256, BK = 64, HALF = 128, HTB = HALF * BK * 2, STAGE_BYTES = 8 * HTB, NXCD = 8, WGM = 8;
__device__ __forceinline__ int lds_byte(int r, int c) { const int st = (r >> 4) * 2 + (c >> 5), rr = r & 15, cc = c & 31, ob = rr * 64 + cc * 2; return st * 1024 + (ob ^ (((ob >> 9) & 1) << 5)); }
__device__ __forceinline__ void stage_rc(int b, int& R, int& C) { const int st = b / 1024, sb = b % 1024, swz = sb ^ (((sb >> 9) & 1) << 5); R = (st >> 1) * 16 + swz / 64; C = (st & 1) * 32 + (swz % 64) / 2; }
__device__ __forceinline__ int perm32(int rho) { const int n = rho >> 4, i = rho & 15; return 8 * (i >> 2) + 4 * n + (i & 3); }

struct Unit { int pm, pn, kind; };
struct Gemm { int lda, ldb, K; };
struct Sched {
    const char* A0; const char* B0; int nM0, nN0, nwg0;
    const char* A1; const char* B1; int nM1, nN1, nwg1;
    size_t tA, tB; int G, c;
    __device__ void init(const void* a0, const void* b0, int M0, int N0, const void* a1, const void* b1, int M1, int N1, int lda, int ldb, int G_, int c_) {
        A0 = (const char*)a0; B0 = (const char*)b0; nM0 = M0 / BM; nN0 = N0 / BM; nwg0 = nM0 * nN0;
        A1 = (const char*)a1; B1 = (const char*)b1; nM1 = M1 / BM; nN1 = N1 / BM; nwg1 = nM1 * nN1;
        tA = (size_t)BM * lda * 2; tB = (size_t)BM * ldb * 2; G = G_; c = c_;
    }
    __device__ __forceinline__ static void map(int wgid, int nwg, int nM, int nN, Unit& u) {
        { const int q = nwg / NXCD, r = nwg % NXCD, xcd = wgid % NXCD, off = wgid / NXCD; wgid = (xcd < r ? xcd * (q + 1) : r * (q + 1) + (xcd - r) * q) + off; }
        const int nig = WGM * nN, gid = wgid / nig, fm = gid * WGM, gsz = (nM - fm) < WGM ? (nM - fm) : WGM;
        u.pm = fm + ((wgid % nig) % gsz); u.pn = (wgid % nig) / gsz;
    }
    __device__ __forceinline__ bool next(int i, Unit& u) const {
        const long L = (long)i * G + c;
        if (L < nwg0) { map((int)L, nwg0, nM0, nN0, u); u.kind = 0; return true; }
        const long L1 = L - nwg0;
        if (L1 < nwg1) { map((int)L1, nwg1, nM1, nN1, u); u.kind = 1; return true; }
        return false;
    }
    __device__ __forceinline__ void ptrs(const Unit& u, const char*& a, const char*& b) const {
        if (u.kind == 0) { a = A0 + (size_t)u.pm * tA; b = B0 + (size_t)u.pn * tB; } else { a = A1 + (size_t)u.pm * tA; b = B1 + (size_t)u.pn * tB; }
    }
};

template <class Epi>
__device__ __forceinline__ void gemm_phase(LAS unsigned char* lds, const Gemm g, const Sched& S, const Epi& E, const int tid) {
    const int wid = __builtin_amdgcn_readfirstlane(tid >> 6), lane = tid & 63, wr = wid >> 2, wc = wid & 3, fr = lane & 15, fq = lane >> 4;
    const int K = g.K, nt = K / BK;
    unsigned voffA[2], voffB[2];
#pragma unroll
    for (int i = 0; i < 2; ++i) { int R, C; stage_rc(tid * 16 + i * 8192, R, C); const int Rb = Epi::PERM ? ((R & ~31) + perm32(R & 31)) : R;
        voffA[i] = (unsigned)(R * g.lda + C) * 2u; voffB[i] = (unsigned)(Rb * g.ldb + C) * 2u; }
    const size_t kstep = (size_t)(BK * 2);
    const size_t hA = (size_t)HALF * g.lda * 2, hB = (size_t)HALF * g.ldb * 2;
    const unsigned ldsw = (unsigned)wid * 1024u;
    const int aoff = lds_byte(wr * 64 + fr, fq * 8), boff = lds_byte(wc * 32 + fr, fq * 8);
#define PG8_SA(b, h) (((b) * 2 + (h)) * HTB)
#define PG8_SB(b, h) ((4 + (b) * 2 + (h)) * HTB)
#define PG8_STAGE(bufoff, gbase, voff) do { _Pragma("unroll") for (int _i = 0; _i < 2; ++_i) \
        __builtin_amdgcn_global_load_lds((const unsigned*)((const char*)(gbase) + (voff)[_i]), (LAS unsigned*)(lds + (bufoff) + ldsw + _i * 8192), 16, 0, 0); } while (0)
#define PG8_LDA(dst, b, h) do { _Pragma("unroll") for (int m = 0; m < 4; ++m) _Pragma("unroll") for (int k = 0; k < 2; ++k) dst[m][k] = *(const LAS bf16x8*)(lds + PG8_SA(b, h) + aoff + m * 2048 + k * 1024); } while (0)
#define PG8_LDB(dst, b, h) do { _Pragma("unroll") for (int n = 0; n < 2; ++n) _Pragma("unroll") for (int k = 0; k < 2; ++k) dst[n][k] = *(const LAS bf16x8*)(lds + PG8_SB(b, h) + boff + n * 2048 + k * 1024); } while (0)
#define PG8_MMA(ai, bj, At, Bt) do { __builtin_amdgcn_s_setprio(1); _Pragma("unroll") for (int m = 0; m < 4; ++m) _Pragma("unroll") for (int n = 0; n < 2; ++n) _Pragma("unroll") for (int k = 0; k < 2; ++k) \
        acc[ai][bj][m][n] = __builtin_amdgcn_mfma_f32_16x16x32_bf16(Bt[n][k], At[m][k], acc[ai][bj][m][n], 0, 0, 0); __builtin_amdgcn_s_setprio(0); } while (0)
#define PG8_WAIT_V(n) asm volatile("s_waitcnt vmcnt(" #n ")" ::: "memory")
#define PG8_WAIT_L(n) asm volatile("s_waitcnt lgkmcnt(" #n ")" ::: "memory")
#define PG8_BAR __builtin_amdgcn_s_barrier()
#define PG8_SCHED __builtin_amdgcn_sched_barrier(0)
    Unit cur, nxt; int ui = 0;
    if (!S.next(0, cur)) return;
    f32x4 acc[2][2][4][2];
#pragma unroll
    for (int a = 0; a < 2; ++a)
#pragma unroll
        for (int b = 0; b < 2; ++b)
#pragma unroll
            for (int m = 0; m < 4; ++m)
#pragma unroll
                for (int n = 0; n < 2; ++n) acc[a][b][m][n] = (f32x4){0.f, 0.f, 0.f, 0.f};
    bf16x8 At[4][2], B0[2][2], B1[2][2];
    const char* cA; const char* cB; S.ptrs(cur, cA, cB);
    PG8_STAGE(PG8_SB(0, 0), cB, voffB); PG8_STAGE(PG8_SB(0, 1), cB + hB, voffB); PG8_STAGE(PG8_SA(0, 0), cA, voffA); PG8_STAGE(PG8_SA(0, 1), cA + hA, voffA);
    if (wr == 1) PG8_BAR;
    PG8_WAIT_V(2); PG8_BAR;
    PG8_STAGE(PG8_SB(1, 0), cB + kstep, voffB); PG8_STAGE(PG8_SA(1, 0), cA + kstep, voffA); PG8_STAGE(PG8_SB(1, 1), cB + hB + kstep, voffB);
    PG8_WAIT_V(6); PG8_BAR;
    for (;;) {
        const bool has_next = S.next(ui + 1, nxt);
        const char* nA = cA; const char* nB = cB; if (has_next) S.ptrs(nxt, nA, nB);
        for (int t = 0; t < nt; t += 2) {
            const bool last = (t == nt - 2);
            const char* a1 = cA + (size_t)(t + 1) * kstep;
            const char* a2 = last ? nA : cA + (size_t)(t + 2) * kstep; const char* b2 = last ? nB : cB + (size_t)(t + 2) * kstep;
            const char* a3 = a2 + kstep; const char* b3 = b2 + kstep;
            PG8_LDB(B0, 0, 0); PG8_LDB(B1, 0, 1); PG8_SCHED; PG8_LDA(At, 0, 0); PG8_STAGE(PG8_SA(1, 1), a1 + hA, voffA);
            PG8_WAIT_V(8); PG8_WAIT_L(0); PG8_BAR; PG8_MMA(0, 0, At, B0); PG8_MMA(0, 1, At, B1); PG8_BAR; PG8_SCHED;
            PG8_LDA(At, 0, 1); PG8_STAGE(PG8_SB(0, 0), b2, voffB); PG8_STAGE(PG8_SB(0, 1), b2 + hB, voffB); PG8_STAGE(PG8_SA(0, 0), a2, voffA);
            PG8_WAIT_V(8); PG8_WAIT_L(0); PG8_BAR; PG8_MMA(1, 0, At, B0); PG8_MMA(1, 1, At, B1); PG8_BAR; PG8_SCHED;
            PG8_LDB(B0, 1, 0); PG8_LDB(B1, 1, 1); PG8_SCHED; PG8_LDA(At, 1, 0); PG8_STAGE(PG8_SA(0, 1), a2 + hA, voffA);
            PG8_WAIT_V(8); PG8_WAIT_L(0); PG8_BAR; PG8_MMA(0, 0, At, B0); PG8_MMA(0, 1, At, B1); PG8_BAR; PG8_SCHED;
            PG8_LDA(At, 1, 1); PG8_STAGE(PG8_SB(1, 0), b3, voffB); PG8_STAGE(PG8_SB(1, 1), b3 + hB, voffB); PG8_STAGE(PG8_SA(1, 0), a3, voffA);
            PG8_WAIT_V(8); PG8_WAIT_L(0); PG8_BAR; PG8_MMA(1, 0, At, B0); PG8_MMA(1, 1, At, B1); PG8_BAR; PG8_SCHED;
        }
        if (wr == 0) PG8_BAR;
        E(acc, cur, wr, wc, fr, fq);
        if (!has_next) break;
#pragma unroll
        for (int a = 0; a < 2; ++a)
#pragma unroll
            for (int b = 0; b < 2; ++b)
#pragma unroll
                for (int m = 0; m < 4; ++m)
#pragma unroll
                    for (int n = 0; n < 2; ++n) acc[a][b][m][n] = (f32x4){0.f, 0.f, 0.f, 0.f};
        cur = nxt; cA = nA; cB = nB; ++ui;
        if (wr == 1) PG8_BAR;
    }
    PG8_WAIT_V(0);
    PG8_BAR;
#undef PG8_SA
#undef PG8_SB
#undef PG8_STAGE
#undef PG8_LDA
#undef PG8_LDB
#undef PG8_MMA
#undef PG8_WAIT_V
#undef PG8_WAIT_L
#undef PG8_BAR
#undef PG8_SCHED
}

struct EpiIn {
    static constexpr bool PERM = true;
    bf16* U; bf16* KVt; bf16* halo;
    __device__ __forceinline__ void operator()(const f32x4 (&acc)[2][2][4][2], const Unit& u, int wr, int wc, int fr, int fq) const {
        bf16* base = u.kind == 0 ? U : KVt; const size_t ldc = u.kind == 0 ? (size_t)UW : (size_t)MT;
        const int row0 = u.pm * BM + wr * 64 + fr, col0 = u.pn * BM + wc * 32 + 8 * fq;
#pragma unroll
        for (int ai = 0; ai < 2; ++ai)
#pragma unroll
            for (int m = 0; m < 4; ++m) { bf16* rowp = base + (size_t)(row0 + ai * HALF + m * 16) * ldc + col0;
#pragma unroll
                for (int bj = 0; bj < 2; ++bj) { const f32x4 v0 = acc[ai][bj][m][0], v1 = acc[ai][bj][m][1];
                    u32x4 w; w.x = pk2(v0[0], v0[1]); w.y = pk2(v0[2], v0[3]); w.z = pk2(v1[0], v1[1]); w.w = pk2(v1[2], v1[3]);
                    *(u32x4*)(rowp + bj * HALF) = w;
                    if (u.kind == 0 && (u.pn >> 2) == 1 && fr >= 13 && (m & 1)) {
                        const int row = row0 + ai * HALF + m * 16;
                        int hidx = -1;
                        if (row >= MP) hidx = 512 + ((row - MP) >> 5); else if (m == 3) hidx = row >> 6;
                        if (hidx >= 0) *(u32x4*)(halo + ((size_t)hidx * 3 + (fr - 13)) * 1024 + (col0 - 1024) + bj * HALF) = w; } } }
    }
};
struct EpiGate {
    static constexpr bool PERM = true;
    const bf16* gate; const bf16* add; bf16* out; bool st;
    __device__ __forceinline__ void operator()(const f32x4 (&acc)[2][2][4][2], const Unit& u, int wr, int wc, int fr, int fq) const {
        const int row0 = u.pm * BM + wr * 64 + fr, col0 = u.pn * BM + wc * 32 + 8 * fq;
#pragma unroll
        for (int ai = 0; ai < 2; ++ai) {
            u32x4 gq[4][2], aq[4][2];
#pragma unroll
            for (int m = 0; m < 4; ++m)
#pragma unroll
                for (int bj = 0; bj < 2; ++bj) { const size_t off = (size_t)(row0 + ai * HALF + m * 16) * UW + col0 + bj * HALF;
                    gq[m][bj] = *(const u32x4*)(gate + off); if (add) aq[m][bj] = *(const u32x4*)(add + off); else aq[m][bj] = (u32x4){0u, 0u, 0u, 0u}; }
#pragma unroll
            for (int m = 0; m < 4; ++m)
#pragma unroll
                for (int bj = 0; bj < 2; ++bj) { const size_t off = (size_t)(row0 + ai * HALF + m * 16) * UW + col0 + bj * HALF;
                    const f32x4 v0 = acc[ai][bj][m][0], v1 = acc[ai][bj][m][1];
                    float gv[8], av[8]; unpack8(gq[m][bj], gv); unpack8(aq[m][bj], av);
                    float o[8];
#pragma unroll
                    for (int e = 0; e < 4; ++e) { o[e] = av[e] + sigmoidf_(gv[e]) * v0[e]; o[4 + e] = av[4 + e] + sigmoidf_(gv[4 + e]) * v1[e]; }
                    u32x4 w; w.x = pk2(o[0], o[1]); w.y = pk2(o[2], o[3]); w.z = pk2(o[4], o[5]); w.w = pk2(o[6], o[7]);
                    if (st) *(u32x4*)(out + off) = w; }
            asm volatile("" ::: "memory");
        }
    }
};
struct EpiRes {
    static constexpr bool PERM = true;
    const float* xp; const float* xs; float* X; const float* gt; bool st;
    __device__ __forceinline__ void operator()(const f32x4 (&acc)[2][2][4][2], const Unit& u, int wr, int wc, int fr, int fq) const {
        const int col0 = u.pn * BM + wc * 32 + 8 * fq;
        const float* g = gt + (size_t)((u.pm * BM) >> 13) * 6144 + col0;
        const float* src = (xp ? xp : X) + (size_t)(u.pm * BM + wr * 64 + fr) * DM + col0;
        float* dst = X + (size_t)(u.pm * BM + wr * 64 + fr) * DM + col0;
        f32x4 gv[2][2];
#pragma unroll
        for (int bj = 0; bj < 2; ++bj)
#pragma unroll
            for (int n = 0; n < 2; ++n) gv[bj][n] = *(const f32x4*)(g + bj * HALF + 4 * n);
#pragma unroll
        for (int ai = 0; ai < 2; ++ai)
#pragma unroll
          for (int mp = 0; mp < 2; ++mp) {
            f32x4 xv[2][2][2];
#pragma unroll
            for (int mm = 0; mm < 2; ++mm)
#pragma unroll
                for (int bj = 0; bj < 2; ++bj)
#pragma unroll
                    for (int n = 0; n < 2; ++n) xv[mm][bj][n] = *(const f32x4*)(src + (size_t)(ai * HALF + (2 * mp + mm) * 16) * DM + bj * HALF + 4 * n);
#pragma unroll
            for (int mm = 0; mm < 2; ++mm)
#pragma unroll
                for (int bj = 0; bj < 2; ++bj)
#pragma unroll
                    for (int n = 0; n < 2; ++n) { const f32x4 o = xv[mm][bj][n] + gv[bj][n] * acc[ai][bj][2 * mp + mm][n];
                        if (st) *(f32x4*)(dst + (size_t)(ai * HALF + (2 * mp + mm) * 16) * DM + bj * HALF + 4 * n) = o; }
            asm volatile("" ::: "memory");
        }
    }
};
struct EpiSwiglu {
    static constexpr bool PERM = true;
    bf16* act;
    __device__ __forceinline__ void operator()(const f32x4 (&acc)[2][2][4][2], const Unit& u, int wr, int wc, int fr, int fq) const {
        const int row0 = u.pm * BM + wr * 64 + fr, col0 = u.pn * HALF + wc * 32 + 8 * fq;
#pragma unroll
        for (int ai = 0; ai < 2; ++ai)
#pragma unroll
            for (int m = 0; m < 4; ++m) { bf16* rowp = act + (size_t)(row0 + ai * HALF + m * 16) * DFF + col0;
                float o[8];
#pragma unroll
                for (int n = 0; n < 2; ++n)
#pragma unroll
                    for (int e = 0; e < 4; ++e) o[4 * n + e] = siluf_(acc[ai][0][m][n][e]) * acc[ai][1][m][n][e];
                u32x4 w; w.x = pk2(o[0], o[1]); w.y = pk2(o[2], o[3]); w.z = pk2(o[4], o[5]); w.w = pk2(o[6], o[7]);
                *(u32x4*)rowp = w; }
    }
};
}


#define XB_TMO      128
#define XB_XCNT(j)  (256  + 64 * (j))
#define XB_XSUB(j)  (1280 + 64 * (j))
#define XB_XGEN(j)  (2304 + 64 * (j))
#define XB_TOP      3328
#define XB_TOPGEN   3392
#define XCD_BAR_WORDS 3456
#define XB_SPIN_CAP (1u << 22)
__device__ __forceinline__ unsigned xb_ld(unsigned* p)              { return __hip_atomic_load(p, __ATOMIC_RELAXED, __HIP_MEMORY_SCOPE_AGENT); }
__device__ __forceinline__ unsigned xb_add(unsigned* p, unsigned v) { return __hip_atomic_fetch_add(p, v, __ATOMIC_RELAXED, __HIP_MEMORY_SCOPE_AGENT); }
__device__ __forceinline__ unsigned xb_xcc_id() { return (unsigned)__builtin_amdgcn_s_getreg((3 << 11) | 20) & 0xFu; }
#define XB_SPIN(cond, bar) do { unsigned _sp = 0; while (cond) { __builtin_amdgcn_s_sleep(1); \
    if ((++_sp & 255u) == 0u) { if (xb_ld(&(bar)[XB_TMO])) break; if (_sp > XB_SPIN_CAP) { atomicAdd(&(bar)[XB_TMO], 1u); break; } } } } while (0)
struct XcdBarrier { unsigned* bar; unsigned x; volatile LAS unsigned* st; };
__device__ __forceinline__ XcdBarrier xcd_barrier_post(unsigned* bar, volatile LAS unsigned* st) {
    XcdBarrier b; b.bar = bar; b.x = xb_xcc_id(); b.st = st;
    if (threadIdx.x == 0) (void)xb_add(&bar[XB_XCNT(b.x)], 1u);
    return b;
}
__device__ __forceinline__ void xcd_barrier_complete(unsigned* bar, unsigned x, unsigned& nloc, unsigned& nx) {
    const unsigned G = gridDim.x * gridDim.y * gridDim.z;
    unsigned sum, cnt, mine, sp = 0u;
    for (;;) {
        sum = 0u; cnt = 0u; mine = 0u;
#pragma unroll
        for (unsigned j = 0; j < 16; ++j) { const unsigned c = xb_ld(&bar[XB_XCNT(j)]); sum += c; cnt += (c > 0u) ? 1u : 0u; mine = (j == x) ? c : mine; }
        if (sum == G) break;
        __builtin_amdgcn_s_sleep(1);
        if ((++sp & 255u) == 0u) { if (xb_ld(&bar[XB_TMO])) break; if (sp > XB_SPIN_CAP) { atomicAdd(&bar[XB_TMO], 1u); break; } }
    }
    nloc = mine > 0u ? mine : 1u; nx = cnt > 0u ? cnt : 1u;
}
__device__ __forceinline__ void xcd_barrier(const XcdBarrier& b) {
    asm volatile("s_waitcnt vmcnt(0)" ::: "memory");
    __syncthreads();
    if (threadIdx.x == 0) {
        unsigned* bar = b.bar;
        __builtin_amdgcn_s_waitcnt(0);
        unsigned nloc = b.st[0], nx = b.st[1];
        if (nloc == 0u) { xcd_barrier_complete(bar, b.x, nloc, nx); b.st[0] = nloc; b.st[1] = nx; }
        const unsigned old = xb_add(&bar[XB_XSUB(b.x)], 1u);
        const unsigned gen = old / nloc;
        if (old + 1u == (gen + 1u) * nloc) {
            __builtin_amdgcn_fence(__ATOMIC_RELEASE, "agent");
            asm volatile("s_waitcnt vmcnt(0)" ::: "memory");
            const unsigned og = xb_add(&bar[XB_TOP], 1u);
            const unsigned tg = og / nx;
            if (og + 1u == (tg + 1u) * nx) xb_add(&bar[XB_TOPGEN], 1u);
            else XB_SPIN(xb_ld(&bar[XB_TOPGEN]) == tg, bar);
            __builtin_amdgcn_fence(__ATOMIC_ACQUIRE, "agent");
            xb_add(&bar[XB_XGEN(b.x)], 1u);
            asm volatile("s_waitcnt vmcnt(0)" ::: "memory");
        } else {
            XB_SPIN(xb_ld(&bar[XB_XGEN(b.x)]) == gen, bar);
            __builtin_amdgcn_fence(__ATOMIC_ACQUIRE, "agent");
            asm volatile("s_waitcnt vmcnt(0)" ::: "memory");
        }
    }
    __syncthreads();
}

struct Args {
    const float* in[26]; float* out; unsigned char* ws;
};

struct Ctx {
    const float* const* in; float* out; unsigned char* ws;
    int tid, lane, wave, G, bid;
    __device__ __forceinline__ bf16* U() const { return (bf16*)(ws + WS_U); }
    __device__ __forceinline__ bf16* KVt() const { return (bf16*)(ws + WS_KVT); }
    __device__ __forceinline__ bf16* XN() const { return (bf16*)(ws + WS_XN); }
    __device__ __forceinline__ bf16* ACT() const { return (bf16*)(ws + WS_U); }
    __device__ __forceinline__ bf16* DC() const { return (bf16*)(ws + WS_XN); }
    __device__ __forceinline__ bf16* DCS() const { return (bf16*)(ws + WS_DCS); }
    __device__ __forceinline__ unsigned char* W() const { return ws + WS_W; }
    __device__ __forceinline__ bf16* HALO() const { return (bf16*)(ws + WS_MODP); }
    __device__ __forceinline__ float* MOD(int l) const { return (float*)(ws + WS_MODP + (4u << 20) + (size_t)l * (1u << 20)); }
    __device__ __forceinline__ float* GATES() const { return (float*)(ws + WS_GATES); }
    __device__ __forceinline__ float* DN() const { return (float*)(ws + WS_DN); }
    __device__ __forceinline__ float* MBM() const { return (float*)(ws + WS_MB); }
    __device__ __forceinline__ float* MBB() const { return (float*)(ws + WS_MB) + (NSLOT_P + NSLOT_S); }
    __device__ __forceinline__ float* MST() const { return (float*)(ws + WS_MB) + 2 * (NSLOT_P + NSLOT_S); }
};

__device__ __forceinline__ void transpose_item(const float* W, int ldw, int K, bf16* WT, int dst_row0, int src_col0, int k0, LAS float* scr, int lane) {
#pragma unroll 8
    for (int i = 0; i < 32; ++i) { const int kk = 2 * i + (lane >> 5); scr[kk * 33 + (lane & 31)] = W[(size_t)(k0 + kk) * ldw + src_col0 + (lane & 31)]; }
    LDS_WAIT();
    const int c = lane & 7;
#pragma unroll
    for (int j = 0; j < 4; ++j) { const int n = (lane >> 3) + 8 * j; const LAS float* s = scr + (8 * c) * 33 + n;
        u32x4 o; o.x = pk2(s[0 * 33], s[1 * 33]); o.y = pk2(s[2 * 33], s[3 * 33]); o.z = pk2(s[4 * 33], s[5 * 33]); o.w = pk2(s[6 * 33], s[7 * 33]);
        *(u32x4*)(WT + (size_t)(dst_row0 + n) * K + k0 + 8 * c) = o; }
    LDS_WAIT();
}
constexpr int CV_IN = 16 * (NWIN / 32), CV_BA = 8 * 32, CV_OUT = 16 * 32, CV_GU = 16 * (2 * DFF / 32), CV_DN = (DFF / 64) * 32;
constexpr int CV_SPLIT = CV_IN + 2 * CV_BA + CV_OUT, CV_ALL = CV_SPLIT + CV_GU + CV_DN;
__device__ __forceinline__ int win_src_col(int n) {
    if (n < 1024) return n;
    if (n < 1536) return 1536 + (n - 1024);
    if (n < 2048) return 2048 + (n - 1536);
    if (n < 2560) return 3072 + (n - 2048);
    if (n < 3584) return 3592 + (n - 2560);
    if (n < 4608) return 4616 + (n - 3584);
    if (n < 5120) return 1024 + (n - 4608);
    if (n < 5632) return 2560 + (n - 5120);
    return 2048 + (n - 5632);
}
__device__ __forceinline__ void phase_convert(Ctx& C, int l, LAS unsigned char* lds, const int it_lo, const int it_hi, const int nmod) {
    LAS float* scr = (LAS float*)(lds + 32768 + C.wave * 8704);
    const int gw = C.bid * 8 + C.wave, NGW = C.G * 8;
    const float* w_in = C.in[13] + (size_t)l * 1024 * INW; const float* w_ba = C.in[19] + (size_t)l * 512 * 1024; const float* w_bm = C.in[20] + (size_t)l * 512 * 1024;
    const float* w_out = C.in[21] + (size_t)l * 1024 * 1024; const float* w_gu = C.in[23] + (size_t)l * 1024 * 2 * DFF; const float* w_dn = C.in[24] + (size_t)l * DFF * 1024;
    constexpr int I_IN = CV_IN, I_BA = CV_BA, I_OUT = CV_OUT, I_GU = CV_GU, I_DN = CV_DN;
    constexpr int NIT = CV_ALL;
    for (int it = it_lo + gw; it < (it_hi < NIT ? it_hi : NIT); it += NGW) {
        int r = it;
        if (r < I_IN) { const int nb = r % (NWIN / 32), kb = r / (NWIN / 32); transpose_item(w_in, INW, 1024, (bf16*)(C.W() + W_IN), nb * 32, win_src_col(nb * 32), kb * 64, scr, C.lane); continue; } r -= I_IN;
        if (r < I_BA) { const int nb = r % 32, kb = r / 32; transpose_item(w_ba, 1024, 512, (bf16*)(C.W() + W_BA), nb * 32, nb * 32, kb * 64, scr, C.lane); continue; } r -= I_BA;
        if (r < I_BA) { const int nb = r % 32, kb = r / 32; transpose_item(w_bm, 1024, 512, (bf16*)(C.W() + W_BM), nb * 32, nb * 32, kb * 64, scr, C.lane); continue; } r -= I_BA;
        if (r < I_OUT) { const int nb = r % 32, kb = r / 32; transpose_item(w_out, 1024, 1024, (bf16*)(C.W() + W_OUT), nb * 32, nb * 32, kb * 64, scr, C.lane); continue; } r -= I_OUT;
        if (r < I_GU) { const int nb = r % (2 * DFF / 32), kb = r / (2 * DFF / 32); const int n0 = nb * 32, t = n0 / 256, hh = (n0 % 256) / 128, j = n0 % 128;
            transpose_item(w_gu, 2 * DFF, 1024, (bf16*)(C.W() + W_GU), n0, hh * DFF + 128 * t + j, kb * 64, scr, C.lane); continue; } r -= I_GU;
        { const int nb = r % 32, kb = r / 32; transpose_item(w_dn, 1024, DFF, (bf16*)(C.W() + W_DN), nb * 32, nb * 32, kb * 64, scr, C.lane); }
    }
    if (nmod == 0) return;
    __syncthreads();

    LAS float* sl = (LAS float*)lds;
    LAS float* red = (LAS float*)(lds + 73728);
    for (int task2 = C.bid; task2 < 96 * nmod; task2 += C.G) {
        const int ml = task2 / 96, task = task2 % 96;
        const float* w_ada = C.in[10] + (size_t)ml * 1024 * 6144; const float* b_ada = C.in[11] + (size_t)ml * 6144;
        const int col = C.tid & 63, ksl = C.tid >> 6, n = task * 64 + col;
        for (int pass = 0; pass < 2; ++pass) {
            for (int i = C.tid; i < 18 * 1024; i += 512) { const int cb = pass * 18 + (i >> 10), k = i & 1023; const float cv = cb < 4 ? C.in[8][cb * 1024 + k] : C.in[9][(cb - 4) * 1024 + k]; sl[i] = siluf_(cv); }
            __syncthreads();
            float a[18];
#pragma unroll
            for (int cb = 0; cb < 18; ++cb) a[cb] = 0.f;
#pragma unroll 1
            for (int kb = 0; kb < 128; kb += 16) { float wv[16];
#pragma unroll
                for (int j = 0; j < 16; ++j) wv[j] = w_ada[(size_t)(ksl * 128 + kb + j) * 6144 + n];
#pragma unroll
                for (int j = 0; j < 16; ++j)
#pragma unroll
                    for (int cb = 0; cb < 18; ++cb) a[cb] += sl[cb * 1024 + ksl * 128 + kb + j] * wv[j]; }
#pragma unroll
            for (int cb = 0; cb < 18; ++cb) red[(ksl * 18 + cb) * 64 + col] = a[cb];
            __syncthreads();
            for (int i = C.tid; i < 18 * 64; i += 512) { const int cb = i >> 6, cc = i & 63; float s = b_ada[task * 64 + cc];
#pragma unroll
                for (int q = 0; q < 8; ++q) s += red[(q * 18 + cb) * 64 + cc];
                C.MOD(ml)[(size_t)(pass * 18 + cb) * 6144 + task * 64 + cc] = s; }
            __syncthreads();
        }
    }
}

template <bool GATES, bool FINAL>
__device__ __forceinline__ void phase_norm(Ctx& C, int l, const float* xp, const float* xs, const float* gvec, int k_sh, int k_sc, LAS unsigned char* lds) {
    LAS float* wgl = (LAS float*)lds;
    if (GATES) {
        const float* w_in = C.in[13] + (size_t)l * 1024 * INW;
        for (int i = C.tid; i < 8192; i += 512) { const int j = i & 7, k = i >> 3; wgl[j * 1024 + k] = w_in[(size_t)k * INW + 3584 + j]; }
        __syncthreads();
    }
    const int gw = C.bid * 8 + C.wave, NGW = C.G * 8, lane = C.lane;
    float* X = C.out;
    constexpr int NR = GATES ? 2 : 4;
    for (int k0 = 0; gw + k0 * NGW < MT; k0 += NR) {
        f32x4 v[NR][4]; float rstd[NR];
#pragma unroll
        for (int q = 0; q < NR; ++q) { int row = gw + (k0 + q) * NGW; row = row < MT ? row : gw;
            const float* xr = xp ? (row < MP ? xp + (size_t)row * DM : xs + (size_t)(row - MP) * DM) : X + (size_t)row * DM;
#pragma unroll
            for (int j = 0; j < 4; ++j) v[q][j] = *(const f32x4*)(xr + lane * 4 + 256 * j); }
#pragma unroll
        for (int q = 0; q < NR; ++q) { float ss = 0.f;
#pragma unroll
            for (int j = 0; j < 4; ++j) ss += (v[q][j].x * v[q][j].x + v[q][j].y * v[q][j].y) + (v[q][j].z * v[q][j].z + v[q][j].w * v[q][j].w);
            rstd[q] = rsqrtf(wave_sum(ss) * (1.f / DM) + EPS); }
#pragma unroll
        for (int q = 0; q < NR; ++q) { const int row = gw + (k0 + q) * NGW;
            if (row >= MT) continue;
            if (FINAL) {
#pragma unroll
                for (int j = 0; j < 4; ++j) { const f32x4 gv = *(const f32x4*)(gvec + lane * 4 + 256 * j); *(f32x4*)(X + (size_t)row * DM + lane * 4 + 256 * j) = v[q][j] * rstd[q] * gv; }
                continue;
            }
            const int cb = row < MP ? (row >> 13) : 4 + ((row - MP) >> 5);
            const float* mod = C.MOD(l) + (size_t)cb * 6144;
            float ga[8];
#pragma unroll
            for (int e = 0; e < 8; ++e) ga[e] = 0.f;
#pragma unroll
            for (int j = 0; j < 4; ++j) { const int c = lane * 4 + 256 * j;
                const f32x4 gv = *(const f32x4*)(gvec + c), sc = *(const f32x4*)(mod + k_sc * 1024 + c), sh = *(const f32x4*)(mod + k_sh * 1024 + c);
                const f32x4 h = v[q][j] * rstd[q] * gv * (sc + 1.f) + sh;
                u32x2 w; w.x = pk2(h.x, h.y); w.y = pk2(h.z, h.w);
                *(u32x2*)(C.XN() + (size_t)row * DM + c) = w;
                if (GATES) {
#pragma unroll
                    for (int e = 0; e < 8; ++e) { const f32x4 wv = *(const LAS f32x4*)(wgl + e * 1024 + c); ga[e] += (h.x * wv.x + h.y * wv.y) + (h.z * wv.z + h.w * wv.w); }
                }
            }
            if (GATES) {
#pragma unroll
                for (int e = 0; e < 8; ++e) ga[e] = wave_sum(ga[e]);
                float mine = ga[0];
#pragma unroll
                for (int e = 1; e < 8; ++e) mine = (lane == e) ? ga[e] : mine;
                if (lane < 8) { float z = mine + C.in[14][l * 8 + lane];
                    if (lane >= 4) z = fminf(z, 0.f) - __builtin_amdgcn_logf(1.f + fexp(-fabsf(z))) * 0.6931471805599453f;
                    C.GATES()[(size_t)row * 8 + lane] = z; }
            }
        }
    }
}

template <bool SAMPLE>
__device__ __forceinline__ void attn_task(Ctx& C, int l, int unit, int h, const LAS float* biasl, LAS s16x8* qfl, const bool st) {
    constexpr int NQB = SAMPLE ? 1 : 2;
    const int lane = C.lane, r = lane & 31, hi = lane >> 5;
    const int rp = (r & 19) | ((r & 4) << 1) | ((r & 8) >> 1);
    const int b = SAMPLE ? unit : unit / NPC, c = SAMPLE ? 0 : unit % NPC;
    const size_t grow0 = SAMPLE ? (size_t)MP + (size_t)unit * TS : (size_t)b * SEQ + (size_t)c * 64;
    const int cc0 = SAMPLE ? 0 : (c > 8 ? c - 8 : 0);
    const int ntile = SAMPLE ? 17 : 2 * (c - cc0 + 1);
    const bf16* U = C.U(); const bf16* KVt = C.KVt();
    const float* cache_k = C.in[2] + ((size_t)(l * NBD + b) * 512) * 512; const float* cache_v = C.in[3] + ((size_t)(l * NBD + b) * 512) * 512;
    const LAS float* bl = biasl + h * 320;
    { s16x8 tq[NQB][4];
#pragma unroll
      for (int qb = 0; qb < NQB; ++qb)
#pragma unroll
        for (int ks = 0; ks < 4; ++ks) tq[qb][ks] = *(const s16x8*)(U + (grow0 + 32 * qb + r) * UW + C_QA + h * 64 + 16 * ks + 8 * hi);
#pragma unroll
      for (int qb = 0; qb < NQB; ++qb)
#pragma unroll
        for (int ks = 0; ks < 4; ++ks) qfl[(qb * 4 + ks) * 64 + lane] = tq[qb][ks];
    }
    LDS_WAIT();
    f32x16 O[NQB][2]; float mrun[NQB], lsum[NQB];
#pragma unroll
    for (int qb = 0; qb < NQB; ++qb) { mrun[qb] = -1e30f; lsum[qb] = 0.f;
#pragma unroll
        for (int db = 0; db < 2; ++db)
#pragma unroll
            for (int i = 0; i < 16; ++i) O[qb][db][i] = 0.f; }
    s16x8 Kc[4], Vc[2][2], Kn[4], Vn[2][2];
    auto load_k = [&](int t, s16x8 (&Kf)[4]) {
        if (!SAMPLE || t == 16) {
            const size_t krow = SAMPLE ? grow0 : (size_t)b * SEQ + (size_t)(cc0 + (t >> 1)) * 64 + 32 * (t & 1);
            const bf16* kp = U + (krow + rp) * UW + C_KA + h * 64 + 8 * hi;
#pragma unroll
            for (int ks = 0; ks < 4; ++ks) Kf[ks] = *(const s16x8*)(kp + 16 * ks);
        } else {
            const float* kp = cache_k + (size_t)(t * 32 + rp) * 512 + h * 64 + 8 * hi;
#pragma unroll
            for (int ks = 0; ks < 4; ++ks) { const f32x4 a = *(const f32x4*)(kp + 16 * ks), bq = *(const f32x4*)(kp + 16 * ks + 4);
                u32x4 w; w.x = pk2(a.x, a.y); w.y = pk2(a.z, a.w); w.z = pk2(bq.x, bq.y); w.w = pk2(bq.z, bq.w); Kf[ks] = __builtin_bit_cast(s16x8, w); }
        }
    };
    auto load_v = [&](int t, s16x8 (&Vf)[2][2]) {
        if (!SAMPLE || t == 16) {
            const size_t krow = SAMPLE ? grow0 : (size_t)b * SEQ + (size_t)(cc0 + (t >> 1)) * 64 + 32 * (t & 1);
#pragma unroll
            for (int db = 0; db < 2; ++db)
#pragma unroll
                for (int s2 = 0; s2 < 2; ++s2) Vf[db][s2] = *(const s16x8*)(KVt + (size_t)(R_VA + h * 64 + 32 * db + r) * MT + krow + 16 * s2 + 8 * hi);
        } else {
#pragma unroll
            for (int db = 0; db < 2; ++db)
#pragma unroll
                for (int s2 = 0; s2 < 2; ++s2) { const float* vp = cache_v + (size_t)(t * 32 + 16 * s2 + 8 * hi) * 512 + h * 64 + 32 * db + r;
                    float x[8];
#pragma unroll
                    for (int e = 0; e < 8; ++e) x[e] = vp[(size_t)e * 512];
                    Vf[db][s2] = pack8(x); }
        }
    };
    load_k(0, Kc); load_v(0, Vc);
    for (int t = 0; t < ntile; ++t) {
        { const int tn = (t + 1 < ntile) ? t + 1 : t; load_k(tn, Kn); load_v(tn, Vn); }
        const int dbase = SAMPLE ? (512 - 32 * t) : ((c - (cc0 + (t >> 1))) * 64 - 32 * (t & 1));
#pragma unroll
        for (int qb = 0; qb < NQB; ++qb) {
            f32x16 S;
#pragma unroll
            for (int i = 0; i < 16; ++i) S[i] = 0.f;
#pragma unroll
            for (int ks = 0; ks < 4; ++ks) S = MFMA32(Kc[ks], qfl[(qb * 4 + ks) * 64 + lane], S);
            const int d0 = dbase + 32 * qb + r - 8 * hi;
            const int dq = dbase + 32 * qb;
            constexpr float SC = 0.125f * LOG2E;
#define KO_(i) (16 * ((i) >> 3) + 4 * (((i) >> 2) & 1) + ((i) & 3))
            float tmax = -1e30f;
            if (dq - 31 >= 256) {
                const float bv = bl[319];
#pragma unroll
                for (int i = 0; i < 16; ++i) { S[i] = S[i] * SC + bv; tmax = fmaxf(tmax, S[i]); }
            } else if (dq + 31 <= 256 && dq - 31 >= -63) {
                const LAS float* bp = bl + (d0 + 63 - 23);
#pragma unroll
                for (int i = 0; i < 16; ++i) { S[i] = S[i] * SC + bp[23 - KO_(i)]; tmax = fmaxf(tmax, S[i]); }
            } else {
#pragma unroll
                for (int i = 0; i < 16; ++i) { int d = d0 - KO_(i); d = d < -63 ? -63 : (d > 256 ? 256 : d);
                    S[i] = S[i] * SC + bl[d + 63]; tmax = fmaxf(tmax, S[i]); }
            }
#undef KO_
            tmax = fmaxf(tmax, __shfl_xor(tmax, 32));
            if (__any(tmax > mrun[qb] + 8.f)) {
                const float mnew = fmaxf(mrun[qb], tmax), alpha = __builtin_amdgcn_exp2f(mrun[qb] - mnew);
                mrun[qb] = mnew; lsum[qb] *= alpha;
#pragma unroll
                for (int db = 0; db < 2; ++db)
#pragma unroll
                    for (int i = 0; i < 16; ++i) O[qb][db][i] *= alpha;
            }
            const float mref = mrun[qb];
            float ps = 0.f;
#pragma unroll
            for (int i = 0; i < 16; ++i) { S[i] = __builtin_amdgcn_exp2f(S[i] - mref); ps += S[i]; }
            lsum[qb] += ps;
#pragma unroll
            for (int s2 = 0; s2 < 2; ++s2) { u32x4 w; w.x = pk2(S[8 * s2], S[8 * s2 + 1]); w.y = pk2(S[8 * s2 + 2], S[8 * s2 + 3]); w.z = pk2(S[8 * s2 + 4], S[8 * s2 + 5]); w.w = pk2(S[8 * s2 + 6], S[8 * s2 + 7]);
                const s16x8 pf = __builtin_bit_cast(s16x8, w);
#pragma unroll
                for (int db = 0; db < 2; ++db) O[qb][db] = MFMA32(Vc[db][s2], pf, O[qb][db]); }
        }
#pragma unroll
        for (int ks = 0; ks < 4; ++ks) Kc[ks] = Kn[ks];
#pragma unroll
        for (int db = 0; db < 2; ++db)
#pragma unroll
            for (int s2 = 0; s2 < 2; ++s2) Vc[db][s2] = Vn[db][s2];
    }
    bf16* Uo = C.U();
#pragma unroll
    for (int qb = 0; qb < NQB; ++qb) {
        const float lt = lsum[qb] + __shfl_xor(lsum[qb], 32), inv = __builtin_amdgcn_rcpf(lt);
        bf16* orow = Uo + (grow0 + 32 * qb + r) * UW + C_QA + h * 64;
#pragma unroll
        for (int db = 0; db < 2; ++db)
#pragma unroll
            for (int i4 = 0; i4 < 4; ++i4) { u32x2 w; w.x = pk2(O[qb][db][4 * i4] * inv, O[qb][db][4 * i4 + 1] * inv); w.y = pk2(O[qb][db][4 * i4 + 2] * inv, O[qb][db][4 * i4 + 3] * inv);
                if (st) *(u32x2*)(orow + 32 * db + 8 * i4 + 4 * hi) = w; }
    }
    LDS_WAIT();
}


__device__ __forceinline__ void attn_sample_wg(Ctx& C, int l, int bd, int h, const LAS float* biasl, LAS float* partO, LAS float* partML, const bool st) {
    const int lane = C.lane, r = lane & 31, hi = lane >> 5, w = C.wave;
    const int rp = (r & 19) | ((r & 4) << 1) | ((r & 8) >> 1);
    const size_t grow0 = (size_t)MP + (size_t)bd * TS;
    const bf16* U = C.U(); const bf16* KVt = C.KVt();
    const float* cache_k = C.in[2] + ((size_t)(l * NBD + bd) * 512) * 512; const float* cache_v = C.in[3] + ((size_t)(l * NBD + bd) * 512) * 512;
    const LAS float* bl = biasl + h * 320;
    s16x8 Qf[4];
#pragma unroll
    for (int ks = 0; ks < 4; ++ks) Qf[ks] = *(const s16x8*)(U + (grow0 + r) * UW + C_QA + h * 64 + 16 * ks + 8 * hi);
    f32x16 O[2]; float mrun = -1e30f, lsum = 0.f;
#pragma unroll
    for (int db = 0; db < 2; ++db)
#pragma unroll
        for (int i = 0; i < 16; ++i) O[db][i] = 0.f;
    for (int t = w; t < 17; t += 8) {
        s16x8 Kf[4], Vf[2][2];
        if (t == 16) {
            const bf16* kp = U + (grow0 + rp) * UW + C_KA + h * 64 + 8 * hi;
#pragma unroll
            for (int ks = 0; ks < 4; ++ks) Kf[ks] = *(const s16x8*)(kp + 16 * ks);
#pragma unroll
            for (int db = 0; db < 2; ++db)
#pragma unroll
                for (int s2 = 0; s2 < 2; ++s2) Vf[db][s2] = *(const s16x8*)(KVt + (size_t)(R_VA + h * 64 + 32 * db + r) * MT + grow0 + 16 * s2 + 8 * hi);
        } else {
            const float* kp = cache_k + (size_t)(t * 32 + rp) * 512 + h * 64 + 8 * hi;
            f32x4 ka[4], kb[4]; float vx[2][2][8];
#pragma unroll
            for (int ks = 0; ks < 4; ++ks) { ka[ks] = *(const f32x4*)(kp + 16 * ks); kb[ks] = *(const f32x4*)(kp + 16 * ks + 4); }
#pragma unroll
            for (int db = 0; db < 2; ++db)
#pragma unroll
                for (int s2 = 0; s2 < 2; ++s2) { const float* vp = cache_v + (size_t)(t * 32 + 16 * s2 + 8 * hi) * 512 + h * 64 + 32 * db + r;
#pragma unroll
                    for (int e = 0; e < 8; ++e) vx[db][s2][e] = vp[(size_t)e * 512]; }
#pragma unroll
            for (int ks = 0; ks < 4; ++ks) { u32x4 ww; ww.x = pk2(ka[ks].x, ka[ks].y); ww.y = pk2(ka[ks].z, ka[ks].w); ww.z = pk2(kb[ks].x, kb[ks].y); ww.w = pk2(kb[ks].z, kb[ks].w); Kf[ks] = __builtin_bit_cast(s16x8, ww); }
#pragma unroll
            for (int db = 0; db < 2; ++db)
#pragma unroll
                for (int s2 = 0; s2 < 2; ++s2) Vf[db][s2] = pack8(vx[db][s2]);
        }
        f32x16 S;
#pragma unroll
        for (int i = 0; i < 16; ++i) S[i] = 0.f;
#pragma unroll
        for (int ks = 0; ks < 4; ++ks) S = MFMA32(Kf[ks], Qf[ks], S);
        const int dq = 512 - 32 * t, d0 = dq + r - 8 * hi;
        constexpr float SC = 0.125f * LOG2E;
#define KO_(i) (16 * ((i) >> 3) + 4 * (((i) >> 2) & 1) + ((i) & 3))
        float tmax = -1e30f;
#pragma unroll
        for (int i = 0; i < 16; ++i) { int d = d0 - KO_(i); d = d < -63 ? -63 : (d > 256 ? 256 : d);
            S[i] = S[i] * SC + bl[d + 63]; tmax = fmaxf(tmax, S[i]); }
#undef KO_
        tmax = fmaxf(tmax, __shfl_xor(tmax, 32));
        const float mnew = fmaxf(mrun, tmax), alpha = __builtin_amdgcn_exp2f(mrun - mnew);
        mrun = mnew;
        float ps = 0.f;
#pragma unroll
        for (int i = 0; i < 16; ++i) { S[i] = __builtin_amdgcn_exp2f(S[i] - mnew); ps += S[i]; }
        lsum = lsum * alpha + ps;
#pragma unroll
        for (int db = 0; db < 2; ++db)
#pragma unroll
            for (int i = 0; i < 16; ++i) O[db][i] *= alpha;
#pragma unroll
        for (int s2 = 0; s2 < 2; ++s2) { u32x4 ww; ww.x = pk2(S[8 * s2], S[8 * s2 + 1]); ww.y = pk2(S[8 * s2 + 2], S[8 * s2 + 3]); ww.z = pk2(S[8 * s2 + 4], S[8 * s2 + 5]); ww.w = pk2(S[8 * s2 + 6], S[8 * s2 + 7]);
            const s16x8 pf = __builtin_bit_cast(s16x8, ww);
#pragma unroll
            for (int db = 0; db < 2; ++db) O[db] = MFMA32(Vf[db][s2], pf, O[db]); }
    }
    const float lt = lsum + __shfl_xor(lsum, 32);
    LAS float* po = partO + (size_t)(w * 64 + lane) * 32;
#pragma unroll
    for (int db = 0; db < 2; ++db)
#pragma unroll
        for (int i4 = 0; i4 < 4; ++i4) *(LAS f32x4*)(po + db * 16 + 4 * i4) = (f32x4){O[db][4 * i4], O[db][4 * i4 + 1], O[db][4 * i4 + 2], O[db][4 * i4 + 3]};
    partML[(w * 64 + lane) * 2] = mrun; partML[(w * 64 + lane) * 2 + 1] = lt;
    __syncthreads();
    {
        float mw[8], lw[8], M = -1e30f;
#pragma unroll
        for (int q = 0; q < 8; ++q) { mw[q] = partML[(q * 64 + lane) * 2]; lw[q] = partML[(q * 64 + lane) * 2 + 1]; M = fmaxf(M, mw[q]); }
        float Lt = 0.f; f32x4 o = (f32x4){0.f, 0.f, 0.f, 0.f};
#pragma unroll
        for (int q = 0; q < 8; ++q) { const float sc = __builtin_amdgcn_exp2f(mw[q] - M); Lt += sc * lw[q];
            const f32x4 pv = *(const LAS f32x4*)(partO + (size_t)(q * 64 + lane) * 32 + 4 * w); o += pv * sc; }
        const float inv = __builtin_amdgcn_rcpf(Lt);
        const int db = w >> 2, i4 = w & 3;
        u32x2 ww; ww.x = pk2(o[0] * inv, o[1] * inv); ww.y = pk2(o[2] * inv, o[3] * inv);
        if (st) *(u32x2*)(C.U() + (grow0 + r) * UW + C_QA + h * 64 + 32 * db + 8 * i4 + 4 * hi) = ww;
    }
    __syncthreads();
}
template <bool SAMPLE>
__device__ __forceinline__ void mstate_task(Ctx& C, int l, int unit, int h, int dblk, LAS float* wbuf) {
    constexpr int L = SAMPLE ? 32 : 64, NKS = L / 16;
    const int lane = C.lane, r = lane & 31, hi = lane >> 5;
    const int b = SAMPLE ? unit : unit / NPC, c = SAMPLE ? 0 : unit % NPC;
    const size_t grow0 = SAMPLE ? (size_t)MP + (size_t)unit * TS : (size_t)b * SEQ + (size_t)c * 64;
    const int slot = SAMPLE ? NSLOT_P + unit * 4 + h : unit * 4 + h;
    const bool first = SAMPLE || c == 0;
    const bool valid = lane < L;
    const float li = valid ? C.GATES()[(grow0 + lane) * 8 + h] : -1e30f, lf = valid ? C.GATES()[(grow0 + lane) * 8 + 4 + h] : 0.f;
    const float bc = scan_add(lf, lane), Bc = __shfl(bc, L - 1);
    const float uu = valid ? Bc - bc + li : -1e30f, Mc = wave_max(uu);
    const float w = valid ? fexp(uu - Mc) : 0.f;
    wbuf[lane] = w;
    LDS_WAIT();
    const int d = 32 * dblk + r;
    const bf16* krow = C.KVt() + (size_t)(R_KM + h * 128 + d) * MT + grow0;
    float dn = 0.f; s16x8 Bf[NKS];
    { u32x4 kq[NKS];
#pragma unroll
      for (int ks = 0; ks < NKS; ++ks) kq[ks] = *(const u32x4*)(krow + 16 * ks + 8 * hi);
#pragma unroll
      for (int ks = 0; ks < NKS; ++ks) { const int s0 = 16 * ks + 8 * hi;
        float kc[8]; unpack8(kq[ks], kc);
        const f32x4 w0 = *(const LAS f32x4*)(wbuf + s0), w1 = *(const LAS f32x4*)(wbuf + s0 + 4);
#pragma unroll
        for (int e = 0; e < 8; ++e) { kc[e] *= (e < 4 ? w0[e] : w1[e - 4]); dn += kc[e]; }
        Bf[ks] = pack8(kc); } }
    bf16* dcp = (SAMPLE ? C.DCS() + (size_t)(slot - NSLOT_P) * 16384 : C.DC() + (size_t)slot * 16384);
#pragma unroll
    for (int vb = 0; vb < 4; ++vb) {
        f32x16 acc;
#pragma unroll
        for (int i = 0; i < 16; ++i) acc[i] = 0.f;
        const bf16* vrow = C.KVt() + (size_t)(R_VM + h * 128 + 32 * vb + r) * MT + grow0 + 8 * hi;
        s16x8 af[NKS];
#pragma unroll
        for (int ks = 0; ks < NKS; ++ks) af[ks] = *(const s16x8*)(vrow + 16 * ks);
#pragma unroll
        for (int ks = 0; ks < NKS; ++ks) acc = MFMA32(af[ks], Bf[ks], acc);
#pragma unroll
        for (int i = 0; i < 16; ++i) { const int v = 32 * vb + 8 * (i >> 2) + 4 * hi + (i & 3); dcp[v * 128 + d] = f2bf(acc[i]); }
    }
    dn += __shfl_xor(dn, 32);
    if (hi == 0) C.DN()[(size_t)slot * 128 + d] = dn;
    if (dblk == 0 && lane == 0) { C.MBM()[slot] = Mc; C.MBB()[slot] = Bc; }
    LDS_WAIT();
}


template <bool SAMPLE>
__device__ __forceinline__ void conv_unit(Ctx& C, int l, int unit) {
    constexpr int L = SAMPLE ? 32 : 64;
    const int ch = 2 * C.tid;
    const size_t grow0 = SAMPLE ? (size_t)MP + (size_t)unit * TS : (size_t)unit * 64;
    bf16* up = C.U() + grow0 * UW + C_QM + ch;
    unsigned xr[L];
#pragma unroll
    for (int rr = 0; rr < L; ++rr) xr[rr] = *(const unsigned*)(up + (size_t)rr * UW);
    const float* cw = C.in[15] + (size_t)l * 4096 + ch; const float* cb = C.in[16] + (size_t)l * 1024 + ch;
    const float w0a = cw[0], w0b = cw[1], w1a = cw[1024], w1b = cw[1025], w2a = cw[2048], w2b = cw[2049], w3a = cw[3072], w3b = cw[3073], ba = cb[0], bb = cb[1];
    const float sc = ch >= 512 ? 0.08838834764831845f : 1.f;
    float a0, a1, a2, b0, b1, b2;
    if (SAMPLE) { const float* cl = C.in[4] + ((size_t)(l * NBD + unit) * 3) * 1024 + ch;
        a0 = cl[0]; b0 = cl[1]; a1 = cl[1024]; b1 = cl[1025]; a2 = cl[2048]; b2 = cl[2049];
    } else if ((unit & (NPC - 1)) == 0) { a0 = a1 = a2 = b0 = b1 = b2 = 0.f;
    } else { const bf16* hp = C.HALO() + (size_t)(unit - 1) * 3 * 1024 + ch;
        const unsigned h0 = *(const unsigned*)hp, h1 = *(const unsigned*)(hp + 1024), h2 = *(const unsigned*)(hp + 2048);
        a0 = bflo(h0); b0 = bfhi(h0); a1 = bflo(h1); b1 = bfhi(h1); a2 = bflo(h2); b2 = bfhi(h2); }
    const bool isk = ch >= 512;
    unsigned ta[L / 2], tb2[L / 2];
    float pa = 0.f, pb = 0.f;
#pragma unroll
    for (int rr = 0; rr < L; ++rr) { const float a3 = bflo(xr[rr]), b3 = bfhi(xr[rr]);
        const float va = ba + w0a * a0 + w1a * a1 + w2a * a2 + w3a * a3, vb = bb + w0b * b0 + w1b * b1 + w2b * b2 + w3b * b3;
        const float oa = siluf_(va) * sc, ob = siluf_(vb) * sc;
        *(unsigned*)(up + (size_t)rr * UW) = pk2(oa, ob);
        if (rr & 1) { ta[rr >> 1] = pk2(pa, oa); tb2[rr >> 1] = pk2(pb, ob); } else { pa = oa; pb = ob; }
        a0 = a1; a1 = a2; a2 = a3; b0 = b1; b1 = b2; b2 = b3; }
    if (isk) {
        bf16* kt = C.KVt() + (size_t)(R_KM + ch - 512) * MT + grow0;
#pragma unroll
        for (int q = 0; q < L / 8; ++q) { u32x4 w0; w0.x = ta[4 * q]; w0.y = ta[4 * q + 1]; w0.z = ta[4 * q + 2]; w0.w = ta[4 * q + 3];
            u32x4 w1; w1.x = tb2[4 * q]; w1.y = tb2[4 * q + 1]; w1.z = tb2[4 * q + 2]; w1.w = tb2[4 * q + 3];
            *(u32x4*)(kt + 8 * q) = w0; *(u32x4*)(kt + MT + 8 * q) = w1; }
    }
}
__device__ __forceinline__ void phase_scan(Ctx& C, int l, const bool st, LAS unsigned char* lds) {
    const int gt = C.bid * 512 + C.tid, NT = C.G * 512;
    for (int e = gt; e < 16 * 8192; e += NT) {
        const int chain = e >> 13, p = e & 8191, b = chain >> 2, h = chain & 3;
        const bool hn = p < 128;
        unsigned* base = (unsigned*)C.DC() + p;
        float* dnb = C.DN() + (hn ? p : 0);
        float c0 = 0.f, c1 = 0.f, m = 0.f, nn = 0.f;
        unsigned buf[16], nb[16]; float fb[16], fnb[16];
#pragma unroll
        for (int j = 0; j < 16; ++j) { buf[j] = base[(size_t)((b * NPC + j) * 4 + h) * 8192]; fb[j] = hn ? dnb[(size_t)((b * NPC + j) * 4 + h) * 128] : 0.f; }
        for (int cg0 = 0; cg0 < NPC; cg0 += 16) {
            if (cg0 + 16 < NPC) {
#pragma unroll
                for (int j = 0; j < 16; ++j) { nb[j] = base[(size_t)((b * NPC + cg0 + 16 + j) * 4 + h) * 8192]; fnb[j] = hn ? dnb[(size_t)((b * NPC + cg0 + 16 + j) * 4 + h) * 128] : 0.f; }
            }
#pragma unroll
            for (int j = 0; j < 16; ++j) { const int slot = (b * NPC + cg0 + j) * 4 + h;
                const float Bc = C.MBB()[slot], Mc = C.MBM()[slot];
                const float mn = fmaxf(Bc + m, Mc), g = fexp(Bc + m - mn), f = fexp(Mc - mn);
                if (st) { base[(size_t)slot * 8192] = pk2(c0, c1); if (hn) { dnb[(size_t)slot * 128] = nn; if (p == 0) C.MST()[slot] = m; } }
                c0 = g * c0 + f * bflo(buf[j]); c1 = g * c1 + f * bfhi(buf[j]); nn = g * nn + f * fb[j]; m = mn; }
#pragma unroll
            for (int j = 0; j < 16; ++j) { buf[j] = nb[j]; fb[j] = fnb[j]; }
        }
        const int v = p >> 6, d = (p & 63) * 2;
        float* o = C.out + O_NCP + ((size_t)(l * NBP + b) * 4 + h) * 16384;
        if (NT == 16 * 8192) {
            LAS float* T8 = (LAS float*)lds;
            T8[d * 9 + (v & 7)] = c0; T8[(d + 1) * 9 + (v & 7)] = c1;
            __syncthreads();
            { const int dd = C.tid >> 2, vq = (C.tid & 3) * 2; const int v0 = (C.bid & 15) * 8;
              if (st) { o[dd * 128 + v0 + vq] = T8[dd * 9 + vq]; o[dd * 128 + v0 + vq + 1] = T8[dd * 9 + vq + 1]; } }
            __syncthreads();
        } else if (st) { o[d * 128 + v] = c0; o[(d + 1) * 128 + v] = c1; }
        if (st) {
            if (hn) { C.out[O_NNP + ((size_t)(l * NBP + b) * 4 + h) * 128 + p] = nn; if (p == 0) C.out[O_NMP + (size_t)(l * NBP + b) * 4 + h] = m; } }
    }
    LAS float* T = (LAS float*)lds;
    __syncthreads();
    for (int task = C.bid; task < NSLOT_S * 2; task += C.G) {
        const int sl = task >> 1, hf = task & 1, slot = NSLOT_P + sl;
#pragma unroll
        for (int j = 0; j < 2; ++j) { const int q = C.tid + 512 * j, v = q >> 3, d8 = (q & 7) * 8;
            float x[8]; unpack8(*(const u32x4*)(C.DCS() + (size_t)sl * 16384 + v * 128 + 64 * hf + d8), x);
#pragma unroll
            for (int e = 0; e < 8; ++e) T[v * 65 + d8 + e] = x[e]; }
        __syncthreads();
        const float m0 = C.in[7][(size_t)l * NSLOT_S + sl], Bc = C.MBB()[slot], Mc = C.MBM()[slot];
        const float mn = fmaxf(Bc + m0, Mc), g = fexp(Bc + m0 - mn), f = fexp(Mc - mn);
        const float* c0p = C.in[5] + ((size_t)l * NSLOT_S + sl) * 16384 + (size_t)hf * 8192;
        float* op = C.out + O_NCS + ((size_t)l * NSLOT_S + sl) * 16384 + (size_t)hf * 8192;
#pragma unroll 4
        for (int j = 0; j < 16; ++j) { const int il = C.tid + 512 * j, dl = il >> 7, v = il & 127;
            op[il] = g * c0p[il] + f * T[v * 65 + dl]; }
        if (hf == 0 && C.tid < 128) { const float n0 = C.in[6][((size_t)l * NSLOT_S + sl) * 128 + C.tid];
            C.out[O_NNS + ((size_t)l * NSLOT_S + sl) * 128 + C.tid] = g * n0 + f * C.DN()[(size_t)slot * 128 + C.tid];
            if (C.tid == 0) C.out[O_NMS + (size_t)l * NSLOT_S + sl] = mn; }
        __syncthreads();
    }
}

template <bool SAMPLE>
__device__ __forceinline__ void conv8(float (&o)[8], const bf16* U, size_t grow, int ts, int ch0, const LAS float* cwl, const float* cleft) {
    float a[8];
    { const f32x4 b0 = *(const LAS f32x4*)(cwl + 4096 + ch0), b1 = *(const LAS f32x4*)(cwl + 4096 + ch0 + 4);
#pragma unroll
      for (int e = 0; e < 4; ++e) { a[e] = b0[e]; a[4 + e] = b1[e]; } }
#pragma unroll
    for (int j = 0; j < 4; ++j) { const int p = ts - 3 + j, pc = p < 0 ? 0 : p;
        float x[8]; unpack8(*(const u32x4*)(U + (grow - ts + pc) * UW + C_QM + ch0), x);
        if (p < 0) {
#pragma unroll
            for (int e = 0; e < 8; ++e) x[e] = SAMPLE ? cleft[(size_t)(p + 3) * 1024 + ch0 + e] : 0.f;
        }
        const f32x4 w0 = *(const LAS f32x4*)(cwl + j * 1024 + ch0), w1 = *(const LAS f32x4*)(cwl + j * 1024 + ch0 + 4);
#pragma unroll
        for (int e = 0; e < 4; ++e) { a[e] += w0[e] * x[e]; a[4 + e] += w1[e] * x[4 + e]; } }
#pragma unroll
    for (int e = 0; e < 8; ++e) o[e] = siluf_(a[e]);
}
template <bool SAMPLE>
__device__ __forceinline__ void mout_task(Ctx& C, int l, int unit, int h, int tb, const LAS float* cwl, const LAS float* gainl, LAS float* gsbuf, LAS s16x8* qfl, const bool st) {
    constexpr int L = SAMPLE ? 32 : 64;
    const int lane = C.lane, r = lane & 31, hi = lane >> 5;
    const int b = SAMPLE ? unit : unit / NPC, c = SAMPLE ? 0 : unit % NPC;
    const size_t grow0 = SAMPLE ? (size_t)MP + (size_t)unit * TS : (size_t)b * SEQ + (size_t)c * 64;
    const int seq0 = SAMPLE ? 0 : c * 64;
    const int slot = SAMPLE ? NSLOT_P + unit * 4 + h : unit * 4 + h;
    const float* cleft = C.in[4] + ((size_t)(l * NBD + b) * 3) * 1024;
    const bool valid = lane < L;
    const float li = valid ? C.GATES()[(grow0 + lane) * 8 + h] : -1e30f, lf = valid ? C.GATES()[(grow0 + lane) * 8 + 4 + h] : 0.f;
    const float bc = scan_add(lf, lane);
    const float gg = valid ? li - bc : -1e30f;
    const float pmx = scan_max(gg, lane);
    const float m0 = SAMPLE ? C.in[7][(size_t)l * NSLOT_S + unit * 4 + h] : C.MST()[slot];
    const float mt_all = fmaxf(bc + m0, bc + pmx);
    gsbuf[lane] = gg;
    const int tl = 32 * tb + r;
    const float bt = __shfl(bc, tl), mt = __shfl(mt_all, tl);
    const float winter = fexp(bt + m0 - mt);
    const size_t trow = grow0 + tl;
    const float* nvec = SAMPLE ? C.in[6] + ((size_t)l * NSLOT_S + unit * 4 + h) * 128 : C.DN() + (size_t)slot * 128;
    float qn = 0.f;
    { s16x8 tq[8];
      const bf16* qp = C.U() + trow * UW + C_QM + h * 128 + 8 * hi;
#pragma unroll
      for (int ks = 0; ks < 8; ++ks) tq[ks] = *(const s16x8*)(qp + 16 * ks);
      LAS float* nb = (LAS float*)(gsbuf + 64);
      { const float n_a = nvec[lane], n_b = nvec[64 + lane]; nb[lane] = n_a; nb[64 + lane] = n_b; }
#pragma unroll
      for (int ks = 0; ks < 8; ++ks) qfl[ks * 64 + lane] = tq[ks];
      LDS_WAIT();
#pragma unroll 1
      for (int ks = 0; ks < 8; ++ks) { float q8[8]; unpack8(__builtin_bit_cast(u32x4, qfl[ks * 64 + lane]), q8);
        const f32x4 n0 = *(const LAS f32x4*)(nb + 16 * ks + 8 * hi), n1 = *(const LAS f32x4*)(nb + 16 * ks + 8 * hi + 4);
#pragma unroll
        for (int e = 0; e < 4; ++e) qn += q8[e] * n0[e] + q8[4 + e] * n1[e]; } }
    qn += __shfl_xor(qn, 32);
    LDS_WAIT();
    f32x16 acc[4];
#pragma unroll
    for (int vb = 0; vb < 4; ++vb)
#pragma unroll
        for (int i = 0; i < 16; ++i) acc[vb][i] = 0.f;
    if (SAMPLE) {
        const float* cp = C.in[5] + ((size_t)l * NSLOT_S + unit * 4 + h) * 16384 + r;
#pragma unroll 1
        for (int ks = 0; ks < 8; ++ks) { const s16x8 qv = qfl[ks * 64 + lane];
#pragma unroll
            for (int vb = 0; vb < 4; ++vb) { float x[8];
#pragma unroll
                for (int e = 0; e < 8; ++e) x[e] = cp[(size_t)(16 * ks + 8 * hi + e) * 128 + 32 * vb];
                acc[vb] = MFMA32(pack8(x), qv, acc[vb]); } }
    } else {
        const bf16* cp = C.DC() + (size_t)slot * 16384 + (size_t)r * 128 + 8 * hi;
#pragma unroll 1
        for (int ks = 0; ks < 8; ++ks) { const s16x8 qv = qfl[ks * 64 + lane];
#pragma unroll
            for (int vb = 0; vb < 4; ++vb) acc[vb] = MFMA32(*(const s16x8*)(cp + (size_t)vb * 4096 + 16 * ks), qv, acc[vb]); }
    }
#pragma unroll
    for (int vb = 0; vb < 4; ++vb)
#pragma unroll
        for (int i = 0; i < 16; ++i) acc[vb][i] *= winter;
    float den = 0.f;
    const int nsb = SAMPLE ? 1 : tb + 1;
#pragma unroll 1
    for (int sb = 0; sb < nsb; ++sb) {
        f32x16 S;
#pragma unroll
        for (int i = 0; i < 16; ++i) S[i] = 0.f;
        const int sl = 32 * sb + r;
        { s16x8 tk[8];
          const bf16* kp = C.U() + (grow0 + sl) * UW + C_KM + h * 128 + 8 * hi;
#pragma unroll
          for (int ks = 0; ks < 8; ++ks) tk[ks] = *(const s16x8*)(kp + 16 * ks);
#pragma unroll
          for (int ks = 0; ks < 8; ++ks) S = MFMA32(tk[ks], qfl[ks * 64 + lane], S); }
        const float e0 = (bt - mt) * LOG2E;
#pragma unroll
        for (int i4 = 0; i4 < 4; ++i4) { const f32x4 gs = *(const LAS f32x4*)(gsbuf + 32 * sb + 8 * i4 + 4 * hi);
#pragma unroll
            for (int e = 0; e < 4; ++e) { const int sidx = 32 * sb + 8 * i4 + 4 * hi + e;
                const float wv = (sidx <= tl) ? __builtin_amdgcn_exp2f(e0 + gs[e] * LOG2E) : 0.f;
                S[4 * i4 + e] *= wv; den += S[4 * i4 + e]; } }
#pragma unroll
        for (int s2 = 0; s2 < 2; ++s2) { u32x4 w; w.x = pk2(S[8 * s2], S[8 * s2 + 1]); w.y = pk2(S[8 * s2 + 2], S[8 * s2 + 3]); w.z = pk2(S[8 * s2 + 4], S[8 * s2 + 5]); w.w = pk2(S[8 * s2 + 6], S[8 * s2 + 7]);
            const s16x8 pf = __builtin_bit_cast(s16x8, w);
            const bf16* vp0 = C.KVt() + (size_t)(R_VM + h * 128 + r) * MT + grow0 + 32 * sb + 16 * s2 + 4 * hi;
#pragma unroll
            for (int vb = 0; vb < 4; ++vb) { const bf16* vp = vp0 + (size_t)(32 * vb) * MT;
                const u32x2 a = *(const u32x2*)vp, bq = *(const u32x2*)(vp + 8); u32x4 vw; vw.x = a.x; vw.y = a.y; vw.z = bq.x; vw.w = bq.y;
                acc[vb] = MFMA32(__builtin_bit_cast(s16x8, vw), pf, acc[vb]); } }
    }
    den += __shfl_xor(den, 32);
    den += winter * qn;
    const float inv = __builtin_amdgcn_rcpf(fmaxf(fabsf(den), fexp(-mt)));
    float ss = 0.f;
#pragma unroll
    for (int vb = 0; vb < 4; ++vb)
#pragma unroll
        for (int i = 0; i < 16; ++i) { acc[vb][i] *= inv; ss += acc[vb][i] * acc[vb][i]; }
    ss += __shfl_xor(ss, 32);
    const float rn = rsqrtf(ss * (1.f / 128.f) + EPS);
    int lane2 = lane; asm volatile("" : "+v"(lane2));
    const int hi2 = lane2 >> 5;
    bf16* orow = C.U() + (grow0 + 32 * tb + (lane2 & 31)) * UW + C_OM + h * 128;
#pragma unroll
    for (int vb = 0; vb < 4; ++vb)
#pragma unroll
        for (int i4 = 0; i4 < 4; ++i4) { const int v0 = 32 * vb + 8 * i4 + 4 * hi2;
            const u32x2 ow = *(const u32x2*)(orow + v0); const f32x4 gn = *(const LAS f32x4*)(gainl + h * 128 + v0);
            const float y0 = acc[vb][4 * i4] * rn * gn[0] * sigmoidf_(bflo(ow.x)), y1 = acc[vb][4 * i4 + 1] * rn * gn[1] * sigmoidf_(bfhi(ow.x));
            const float y2 = acc[vb][4 * i4 + 2] * rn * gn[2] * sigmoidf_(bflo(ow.y)), y3 = acc[vb][4 * i4 + 3] * rn * gn[3] * sigmoidf_(bfhi(ow.y));
            u32x2 w; w.x = pk2(y0, y1); w.y = pk2(y2, y3); if (st) *(u32x2*)(orow + v0) = w; if (i4 == 3) asm volatile("" ::: "memory"); }
    LDS_WAIT();
}


template <class F>
__device__ __forceinline__ void mini_gemm(Ctx& C, const bf16* A, int lda, const bf16* Bt, int K, LAS unsigned char* lds, const F& epi) {
    const int lane = C.lane, r = lane & 31, hi = lane >> 5, w = C.wave, sm = w & 1, sn = (w >> 1) & 1, kh = w >> 2;
    LAS float* red = (LAS float*)lds + (w & 3) * 1024;
    for (int tile = C.bid; tile < 256; tile += C.G) {
        const int tm = tile >> 4, tn = tile & 15;
        const int row0 = MP + 64 * tm + 32 * sm, col0 = 64 * tn + 32 * sn, kh0 = kh * (K >> 1);
        const bf16* pa = A + (size_t)(row0 + r) * lda + kh0 + 8 * hi;
        const bf16* pb = Bt + (size_t)(col0 + r) * K + kh0 + 8 * hi;
        f32x16 acc;
#pragma unroll
        for (int i = 0; i < 16; ++i) acc[i] = 0.f;
#pragma unroll 16
        for (int k = 0; k < (K >> 1); k += 16) acc = MFMA32(*(const s16x8*)(pa + k), *(const s16x8*)(pb + k), acc);
        if (kh == 1) {
#pragma unroll
            for (int i = 0; i < 16; ++i) red[i * 64 + lane] = acc[i];
        }
        __syncthreads();
        if (kh == 0) {
            f32x2_t pre[16];
#pragma unroll
            for (int i = 0; i < 16; ++i) pre[i] = epi.pre(row0 + 8 * (i >> 2) + 4 * hi + (i & 3), col0 + r);
#pragma unroll
            for (int i = 0; i < 16; ++i) { const float v = acc[i] + red[i * 64 + lane];
                epi.fin(row0 + 8 * (i >> 2) + 4 * hi + (i & 3), col0 + r, v, pre[i]); }
        }
        __syncthreads();
    }
}

struct MiniGate {
    bf16* U; int cgate; int cadd; bool st;
    __device__ __forceinline__ f32x2_t pre(int rr, int cc) const { const bf16* p = U + (size_t)rr * UW + cc; f32x2_t o; o.x = bf1(p[cgate]); o.y = cadd >= 0 ? bf1(p[cadd]) : 0.f; return o; }
    __device__ __forceinline__ void fin(int rr, int cc, float v, f32x2_t p) const { if (st) U[(size_t)rr * UW + cgate + cc] = f2bf(p.y + sigmoidf_(p.x) * v); }
};
struct MiniRes {
    const float* xs; float* X; const float* gt; bool st;
    __device__ __forceinline__ f32x2_t pre(int rr, int cc) const { const int rs = rr - MP; f32x2_t o; o.x = xs[(size_t)rs * DM + cc]; o.y = gt[(size_t)(4 + (rs >> 5)) * 6144 + cc]; return o; }
    __device__ __forceinline__ void fin(int rr, int cc, float v, f32x2_t p) const { if (st) X[(size_t)rr * DM + cc] = p.x + p.y * v; }
};
constexpr int LDS_BYTES = 131072 + 2048;
__global__ void __launch_bounds__(512) fwd_megakernel(Args args) {
    extern __shared__ __attribute__((aligned(16))) unsigned char lds_raw[];
    LAS unsigned char* lds = (LAS unsigned char*)lds_raw;
    cg::grid_group grid = cg::this_grid();
    Ctx C;
    C.in = args.in; C.out = args.out; C.ws = args.ws;
    volatile LAS unsigned* bst = (volatile LAS unsigned*)(lds + 131072 + 1024);
    if (threadIdx.x < 2) bst[threadIdx.x] = 0u;
    __syncthreads();
    (void)xcd_barrier_post((unsigned*)(args.ws + WS_CTL), bst);
    C.tid = threadIdx.x; C.lane = C.tid & 63; C.wave = __builtin_amdgcn_readfirstlane(C.tid >> 6); C.G = gridDim.x; C.bid = blockIdx.x;
    float* X = C.out;
#define PHASE_BEGIN() do { int t_ = C.tid; asm volatile("" : "+v"(t_)); C.tid = t_; C.lane = t_ & 63; C.wave = __builtin_amdgcn_readfirstlane(t_ >> 6); \
        int g_ = C.G, b_ = C.bid; asm volatile("" : "+s"(g_), "+s"(b_)); C.G = g_; C.bid = b_; } while (0)

#define GSYNC() do { XcdBarrier xb_; xb_.bar = (unsigned*)(C.ws + WS_CTL); xb_.x = xb_xcc_id(); xb_.st = (volatile LAS unsigned*)(lds + 131072 + 1024); xcd_barrier(xb_); } while (0)
    for (int l = 0; l < 2; ++l) {
        PHASE_BEGIN();
        if (l == 0) {
            for (int rep = 0; rep < REP_MISC; ++rep) { phase_convert(C, 0, lds, 0, CV_ALL, 2); __syncthreads(); PHASE_BEGIN(); }
            if (C.ws == nullptr) grid.sync();
            GSYNC();
            PHASE_BEGIN();
        }
        if (l == 1) { phase_convert(C, 1, lds, CV_SPLIT, CV_ALL, 0); PHASE_BEGIN(); }
        for (int rep = 0; rep < REP_MISC; ++rep) { phase_norm<true, false>(C, l, l == 0 ? C.in[0] : nullptr, C.in[1], C.in[12] + l * 1024, 0, 1, lds); __syncthreads(); PHASE_BEGIN(); }
        GSYNC(); PHASE_BEGIN();
        {
            pg8::Gemm g{1024, 1024, 1024}; pg8::Sched S;
            S.init(C.XN(), C.W() + W_IN, MT, UW, C.W() + W_IN + (size_t)UW * 1024 * 2, C.XN(), 1024, MT, 1024, 1024, C.G, C.bid);
            pg8::EpiIn E{C.U(), C.KVt(), C.HALO()};
            for (int rep = 0; rep < REP_GEMM; ++rep) { pg8::gemm_phase(lds, g, S, E, C.tid); PHASE_BEGIN(); }
        }
        GSYNC(); PHASE_BEGIN();
        {
            LAS float* biasl = (LAS float*)lds;
            LAS float* wb = (LAS float*)(lds + 16384) + C.wave * 64;
            LAS s16x8* qfa = (LAS s16x8*)(lds + 32768) + C.wave * 512;
            for (int i = C.tid; i < 8 * 320; i += 512) biasl[i] = C.in[17][(size_t)l * 8 * 320 + i] * LOG2E;
            __syncthreads();
            constexpr int NA_S = NBD, NA_P = NBP * NPC, NM_S = NBD * 2, NM_P = NBP * NPC * 2;
            for (int rep = 0; rep < REP_P3; ++rep) { const bool st = (rep == REP_P3 - 1) || (C.ws == nullptr);
            for (int u = C.bid; u < NBD * 8; u += C.G) { PHASE_BEGIN(); attn_sample_wg(C, l, u >> 3, u & 7, biasl, (LAS float*)(lds + 32768), (LAS float*)(lds + 98304), st); }
            if (C.G == 256) {
                for (int i = 0; i < 2; ++i) { PHASE_BEGIN(); attn_task<false>(C, l, (C.bid & 7) * 64 + i * 32 + (C.bid >> 3), C.wave, biasl, qfa, st); }
            } else {
                for (int u = C.bid; u < NA_P; u += C.G) { PHASE_BEGIN(); attn_task<false>(C, l, u, C.wave, biasl, qfa, st); }
            }
            if (rep == REP_P3 - 1) {
                for (int u = C.bid; u < NBD + NBP * NPC; u += C.G) { PHASE_BEGIN(); if (u < NBD) conv_unit<true>(C, l, u); else conv_unit<false>(C, l, u - NBD); }
            }
            }
            PHASE_BEGIN();
            for (int rep = 0; rep < REP_COPY; ++rep) {
            const int gt = C.bid * 512 + C.tid, NT = C.G * 512;
            for (int e = gt; e < NBP * 512 * 512; e += NT) { const int b = e >> 18, t = (e >> 9) & 511, cc = e & 511; const size_t row = (size_t)b * SEQ + 7680 + t;
                C.out[O_NKP + (size_t)l * NBP * 262144 + e] = bf1(C.U()[row * UW + C_KA + cc]); }
            {
                LAS float* T = (LAS float*)(lds + 32768);
                __syncthreads();
                for (int tile = C.bid; tile < NBP * 64; tile += C.G) {
                    const int b = tile >> 6, tb = (tile >> 3) & 7, cb8 = tile & 7;
                    { const int ccl = C.tid >> 3, t8 = (C.tid & 7) * 8; const size_t row = (size_t)b * SEQ + 7680 + tb * 64 + t8;
                      float x[8]; unpack8(*(const u32x4*)(C.KVt() + (size_t)(R_VA + cb8 * 64 + ccl) * MT + row), x);
#pragma unroll
                      for (int e = 0; e < 8; ++e) T[ccl * 65 + t8 + e] = x[e]; }
                    __syncthreads();
                    { const int tl = C.tid >> 3, c8 = (C.tid & 7) * 8;
                      float* o = C.out + O_NVP + (size_t)l * NBP * 262144 + ((size_t)b * 512 + tb * 64 + tl) * 512 + cb8 * 64 + c8;
                      f32x4 a, c;
                      a.x = T[(c8 + 0) * 65 + tl]; a.y = T[(c8 + 1) * 65 + tl]; a.z = T[(c8 + 2) * 65 + tl]; a.w = T[(c8 + 3) * 65 + tl];
                      c.x = T[(c8 + 4) * 65 + tl]; c.y = T[(c8 + 5) * 65 + tl]; c.z = T[(c8 + 6) * 65 + tl]; c.w = T[(c8 + 7) * 65 + tl];
                      *(f32x4*)o = a; *(f32x4*)(o + 4) = c; }
                    __syncthreads();
                }
            }
            for (int e = gt; e < NBD * TS * 512; e += NT) { const int bd = e >> 14, t = (e >> 9) & 31, cc = e & 511; const size_t row = (size_t)MP + bd * TS + t;
                C.out[O_NKS + (size_t)l * NBD * TS * 512 + e] = bf1(C.U()[row * UW + C_KA + cc]);
                C.out[O_NVS + (size_t)l * NBD * TS * 512 + e] = bf1(C.KVt()[(size_t)(R_VA + cc) * MT + row]); }
            for (int e = gt; e < NBP * 3 * 1024; e += NT) { const int b = e / 3072, j = (e / 1024) % 3, ch = e & 1023;
                C.out[O_NCVP + (size_t)l * NBP * 3072 + e] = bf1(C.HALO()[((size_t)(b * NPC + NPC - 1) * 3 + j) * 1024 + ch]); }
            for (int e = gt; e < NBD * 3 * 1024; e += NT) { const int bd = e / 3072, j = (e / 1024) % 3, ch = e & 1023;
                C.out[O_NCVS + (size_t)l * NBD * 3072 + e] = bf1(C.HALO()[((size_t)(512 + bd) * 3 + j) * 1024 + ch]); }
            PHASE_BEGIN(); }
        }
        GSYNC(); PHASE_BEGIN();
        {
            LAS float* wb = (LAS float*)(lds + 16384) + C.wave * 64;
            constexpr int NM_S = NBD * 2, NM_P = NBP * NPC * 2;
            for (int u = C.bid; u < NM_S + NM_P; u += C.G) {
                PHASE_BEGIN();
                if (u < NM_S) mstate_task<true>(C, l, u >> 1, 2 * (u & 1) + (C.wave >> 2), C.wave & 3, wb);
                else { const int v = u - NM_S; mstate_task<false>(C, l, v >> 1, 2 * (v & 1) + (C.wave >> 2), C.wave & 3, wb); }
            }
        }
        GSYNC(); PHASE_BEGIN();
        for (int rep = 0; rep < REP_SYNC; ++rep) GSYNC();
        for (int rep = 0; rep < REP_SCAN; ++rep) { phase_scan(C, l, (rep == REP_SCAN - 1) || (C.ws == nullptr), lds); PHASE_BEGIN(); }
        GSYNC(); PHASE_BEGIN();
        {
            LAS float* cwl = (LAS float*)lds;
            LAS float* gainl = cwl + 5 * 1024;
            LAS float* gsb = gainl + 512 + C.wave * 192;
            LAS s16x8* qfl = (LAS s16x8*)(lds + 32768) + C.wave * 512;
            for (int i = C.tid; i < 4096; i += 512) cwl[i] = C.in[15][(size_t)l * 4096 + i];
            for (int i = C.tid; i < 1024; i += 512) cwl[4096 + i] = C.in[16][(size_t)l * 1024 + i];
            gainl[C.tid] = C.in[18][(size_t)l * 512 + C.tid];
            __syncthreads();
            constexpr int NU_S = NBD * 4 / 8, NU_P = NBP * NPC;
            for (int rep = 0; rep < REP_MOUT; ++rep) { const bool st = (rep == REP_MOUT - 1) || (C.ws == nullptr);
            for (int u = C.bid, it = 0; u < NU_P; u += C.G, ++it) {
                PHASE_BEGIN();
                mout_task<false>(C, l, u, C.wave >> 1, C.wave & 1, cwl, gainl, gsb, qfl, st);
                if (it == 0 && C.wave == 0 && C.bid < NBD * 4) mout_task<true>(C, l, C.bid >> 2, C.bid & 3, 0, cwl, gainl, gsb, qfl, st);
            }
            }
        }
        GSYNC(); PHASE_BEGIN();
        {
            pg8::Gemm g{UW, 512, 512}; pg8::Sched S;
            S.init(C.U() + C_QA, C.W() + W_BA, MT, 1024, nullptr, nullptr, 0, 0, UW, 512, C.G, C.bid);
            for (int rep = 0; rep < REP_N1024; ++rep) { const bool st = (rep == REP_N1024 - 1) || (C.ws == nullptr);
            S.init(C.U() + C_QA, C.W() + W_BA, MP, 1024, nullptr, nullptr, 0, 0, UW, 512, C.G, C.bid);
            pg8::EpiGate E{C.U() + C_GA, nullptr, C.U() + C_GA, st};
            pg8::gemm_phase(lds, g, S, E, C.tid);
            { MiniGate mg{C.U(), C_GA, -1, st}; mini_gemm(C, C.U() + C_QA, UW, (const bf16*)(C.W() + W_BA), 512, lds, mg); }
            __threadfence(); __syncthreads(); PHASE_BEGIN();
            S.init(C.U() + C_OM, C.W() + W_BM, MP, 1024, nullptr, nullptr, 0, 0, UW, 512, C.G, C.bid);
            pg8::EpiGate E2{C.U() + C_GM, C.U() + C_GA, C.U() + C_GM, st};
            pg8::gemm_phase(lds, g, S, E2, C.tid);
            { MiniGate mg{C.U(), C_GM, C_GA, st}; mini_gemm(C, C.U() + C_OM, UW, (const bf16*)(C.W() + W_BM), 512, lds, mg); }
            PHASE_BEGIN(); }
        }
        GSYNC(); PHASE_BEGIN();
        {
            pg8::Gemm g{UW, 1024, 1024}; pg8::Sched S;
            S.init(C.U() + C_GM, C.W() + W_OUT, MP, 1024, nullptr, nullptr, 0, 0, UW, 1024, C.G, C.bid);
            for (int rep = 0; rep < REP_N1024; ++rep) { const bool st = (rep == REP_N1024 - 1) || (C.ws == nullptr);
            pg8::EpiRes E{l == 0 ? C.in[0] : nullptr, C.in[1], X, C.MOD(l) + 2 * 1024, st};
            pg8::gemm_phase(lds, g, S, E, C.tid);
            { MiniRes mr{l == 0 ? C.in[1] : X + (size_t)MP * DM, X, C.MOD(l) + 2 * 1024, st}; mini_gemm(C, C.U() + C_GM, UW, (const bf16*)(C.W() + W_OUT), 1024, lds, mr); }
            PHASE_BEGIN(); }
        }
        GSYNC(); PHASE_BEGIN();
        if (l == 0) { phase_convert(C, 1, lds, 0, CV_SPLIT, 0); PHASE_BEGIN(); }
        for (int rep = 0; rep < REP_MISC; ++rep) { phase_norm<false, false>(C, l, nullptr, nullptr, C.in[22] + l * 1024, 3, 4, lds); __syncthreads(); PHASE_BEGIN(); }
        GSYNC(); PHASE_BEGIN();
        {
            pg8::Gemm g{1024, 1024, 1024}; pg8::Sched S;
            S.init(C.XN(), C.W() + W_GU, MT, 2 * DFF, nullptr, nullptr, 0, 0, 1024, 1024, C.G, C.bid);
            pg8::EpiSwiglu E{C.ACT()};
            for (int rep = 0; rep < REP_GEMM; ++rep) { pg8::gemm_phase(lds, g, S, E, C.tid); PHASE_BEGIN(); }
        }
        GSYNC(); PHASE_BEGIN();
        {
            pg8::Gemm g{DFF, DFF, DFF}; pg8::Sched S;
            S.init(C.ACT(), C.W() + W_DN, MP, 1024, nullptr, nullptr, 0, 0, DFF, DFF, C.G, C.bid);
            for (int rep = 0; rep < REP_N1024; ++rep) { const bool st = (rep == REP_N1024 - 1) || (C.ws == nullptr);
            pg8::EpiRes E{nullptr, nullptr, X, C.MOD(l) + 5 * 1024, st};
            pg8::gemm_phase(lds, g, S, E, C.tid);
            { MiniRes mr{X + (size_t)MP * DM, X, C.MOD(l) + 5 * 1024, st}; mini_gemm(C, C.ACT(), DFF, (const bf16*)(C.W() + W_DN), DFF, lds, mr); }
            PHASE_BEGIN(); }
        }
        GSYNC(); PHASE_BEGIN();
    }
    phase_norm<false, true>(C, 0, nullptr, nullptr, C.in[25], 0, 0, lds);
}

extern "C" void kernel_launch(void* const* d_in, const int* in_sizes, int n_in, void* d_out, int out_size, void* d_ws, size_t ws_size, hipStream_t stream) {
    static int grid = 0;
    if (grid == 0) {
        if (n_in != 26 || (size_t)out_size != O_END || ws_size < WS_CTL + CTL_BYTES) { fprintf(stderr, "kernel_launch: unexpected shapes (n_in %d out %d ws %zu)\n", n_in, out_size, ws_size); grid = -1; return; }
        int dev = 0, cus = 0, per_cu = 0;
        hipGetDevice(&dev); hipDeviceGetAttribute(&cus, hipDeviceAttributeMultiprocessorCount, dev);
        hipFuncSetAttribute((const void*)fwd_megakernel, hipFuncAttributeMaxDynamicSharedMemorySize, LDS_BYTES);
        hipOccupancyMaxActiveBlocksPerMultiprocessor(&per_cu, (const void*)fwd_megakernel, 512, LDS_BYTES);
        (void)hipGetLastError();
        if (per_cu < 1) per_cu = 1;
        grid = cus * 1;
    }
    if (grid < 0) return;
    Args a{};
    for (int i = 0; i < 26; ++i) a.in[i] = (const float*)d_in[i];
    a.out = (float*)d_out; a.ws = (unsigned char*)d_ws;
    if (hipMemsetAsync((char*)d_ws + WS_CTL, 0, CTL_BYTES, stream) != hipSuccess) { fprintf(stderr, "memset failed\n"); return; }
    void* kargs[] = {&a};
    hipError_t e = hipLaunchCooperativeKernel((const void*)fwd_megakernel, dim3(grid), dim3(512), kargs, LDS_BYTES, stream);
    if (e != hipSuccess) fprintf(stderr, "cooperative launch failed: %s (grid %d)\n", hipGetErrorString(e), grid);
}
```

```cpp
#include <hip/hip_runtime.h>
#include <hip/hip_cooperative_groups.h>
#include <cstdio>
#include <cstdint>
namespace cg = cooperative_groups;
#ifndef REP_GEMM
#define REP_GEMM 1
#endif
#ifndef REP_SYNC
#define REP_SYNC 0
#endif
#ifndef REP_P3
#define REP_P3 1
#endif
#ifndef REP_MOUT
#define REP_MOUT 1
#endif
#ifndef REP_SCAN
#define REP_SCAN 1
#endif
#ifndef REP_N1024
#define REP_N1024 1
#endif
#ifndef REP_COPY
#define REP_COPY 1
#endif
#ifndef REP_MISC
#define REP_MISC 1
#endif

#define LAS __attribute__((address_space(3)))
typedef unsigned short bf16;
typedef short s16x8 __attribute__((ext_vector_type(8)));
typedef float f32x4 __attribute__((ext_vector_type(4)));
typedef float f32x16 __attribute__((ext_vector_type(16)));
typedef unsigned u32x4 __attribute__((ext_vector_type(4)));
typedef unsigned u32x2 __attribute__((ext_vector_type(2)));
typedef float f32x2_t __attribute__((ext_vector_type(2)));
typedef __bf16 bf16x2_t __attribute__((ext_vector_type(2)));

constexpr int DM = 1024, MP = 32768, MS = 1024, MT = MP + MS, SEQ = 8192, NBP = 4, NBD = 32, TS = 32, NCB = 36;
constexpr int UW = 4608;
constexpr int C_QA = 0, C_KA = 512, C_QM = 1024, C_KM = 1536, C_OM = 2048, C_GA = 2560, C_GM = 3584;
constexpr int R_VA = 0, R_VM = 512, R_KM = 1024, KVR = 1536;
constexpr int DFF = 2816, INW = 5640, NWIN = UW + 1024;
constexpr float EPS = 1e-6f, LOG2E = 1.44269504089f;
constexpr int NPC = 128;
constexpr int NSLOT_P = NBP * NPC * 4, NSLOT_S = NBD * 4;

constexpr size_t O_Y = 0;
constexpr size_t O_NKP = (size_t)MT * DM;
constexpr size_t O_NVP = O_NKP + 2ull * 4 * 512 * 512;
constexpr size_t O_NCVP = O_NVP + 2ull * 4 * 512 * 512;
constexpr size_t O_NCP = O_NCVP + 2ull * 4 * 3 * 1024;
constexpr size_t O_NNP = O_NCP + 2ull * 4 * 4 * 16384;
constexpr size_t O_NMP = O_NNP + 2ull * 4 * 4 * 128;
constexpr size_t O_NKS = O_NMP + 2ull * 4 * 4;
constexpr size_t O_NVS = O_NKS + 2ull * 32 * 32 * 512;
constexpr size_t O_NCVS = O_NVS + 2ull * 32 * 32 * 512;
constexpr size_t O_NCS = O_NCVS + 2ull * 32 * 3 * 1024;
constexpr size_t O_NNS = O_NCS + 2ull * 32 * 4 * 16384;
constexpr size_t O_NMS = O_NNS + 2ull * 32 * 4 * 128;
constexpr size_t O_END = O_NMS + 2ull * 32 * 4;
static_assert(O_END == 45871392ull, "output size");

constexpr size_t al4k(size_t x) { return (x + 4095) & ~(size_t)4095; }
constexpr size_t WS_U = 0;
constexpr size_t WS_KVT = al4k(WS_U + (size_t)MT * UW * 2);
constexpr size_t WS_XN = al4k(WS_KVT + (size_t)KVR * MT * 2);
constexpr size_t WS_W = al4k(WS_XN + (size_t)MT * DM * 2);
constexpr size_t W_IN = 0, W_BA = W_IN + (size_t)NWIN * 1024 * 2, W_BM = W_BA + 1024 * 512 * 2, W_OUT = W_BM + 1024 * 512 * 2,
                 W_GU = W_OUT + 1024 * 1024 * 2, W_DN = W_GU + (size_t)2 * DFF * 1024 * 2, W_END = W_DN + (size_t)1024 * DFF * 2;
constexpr size_t WS_MODP = al4k(WS_W + W_END);
constexpr size_t WS_MOD = al4k(WS_MODP + 8ull * NCB * 6144 * 4);
constexpr size_t WS_GATES = al4k(WS_MOD + (size_t)NCB * 6144 * 4);
constexpr size_t WS_DN = al4k(WS_GATES + (size_t)MT * 8 * 4);
constexpr size_t WS_MB = al4k(WS_DN + (size_t)(NSLOT_P + NSLOT_S) * 128 * 4);
constexpr size_t WS_DCS = al4k(WS_MB + (size_t)(NSLOT_P + NSLOT_S) * 4 * 3);
constexpr size_t WS_END = al4k(WS_DCS + (size_t)NSLOT_S * 16384 * 2);
constexpr size_t WS_CTL = WS_END, CTL_BYTES = 16384;
static_assert(WS_CTL + CTL_BYTES <= 512ull * 1024 * 1024, "workspace map exceeds 512 MiB");
static_assert((size_t)NSLOT_P * 16384 * 2 <= (size_t)MT * DM * 2, "dC overlay fits in XN");

__device__ __forceinline__ unsigned pk2(float lo, float hi) { f32x2_t v = {lo, hi}; bf16x2_t b = __builtin_convertvector(v, bf16x2_t); return __builtin_bit_cast(unsigned, b); }
__device__ __forceinline__ float bflo(unsigned w) { return __uint_as_float(w << 16); }
__device__ __forceinline__ float bfhi(unsigned w) { return __uint_as_float(w & 0xffff0000u); }
__device__ __forceinline__ float bf1(bf16 h) { return __uint_as_float((unsigned)h << 16); }
__device__ __forceinline__ bf16 f2bf(float f) { return (bf16)(pk2(f, 0.f) & 0xffffu); }
__device__ __forceinline__ float fexp(float x) { return __builtin_amdgcn_exp2f(x * LOG2E); }
__device__ __forceinline__ float sigmoidf_(float x) { return __builtin_amdgcn_rcpf(1.f + fexp(-x)); }
__device__ __forceinline__ float siluf_(float x) { return x * __builtin_amdgcn_rcpf(1.f + fexp(-x)); }
__device__ __forceinline__ float wave_sum(float v) {
#pragma unroll
    for (int o = 1; o < 64; o <<= 1) v += __shfl_xor(v, o);
    return v;
}
__device__ __forceinline__ float wave_max(float v) {
#pragma unroll
    for (int o = 1; o < 64; o <<= 1) v = fmaxf(v, __shfl_xor(v, o));
    return v;
}
__device__ __forceinline__ float scan_add(float x, int lane) {
#pragma unroll
    for (int o = 1; o < 64; o <<= 1) { float v = __shfl_up(x, o); if (lane >= o) x += v; }
    return x;
}
__device__ __forceinline__ float scan_max(float x, int lane) {
#pragma unroll
    for (int o = 1; o < 64; o <<= 1) { float v = __shfl_up(x, o); if (lane >= o) x = fmaxf(x, v); }
    return x;
}
#define LDS_WAIT() asm volatile("s_waitcnt lgkmcnt(0)" ::: "memory")
#define MFMA32(a, b, c) __builtin_amdgcn_mfma_f32_32x32x16_bf16((a), (b), (c), 0, 0, 0)
__device__ __forceinline__ s16x8 pack8(const float (&x)[8]) { u32x4 p; p.x = pk2(x[0], x[1]); p.y = pk2(x[2], x[3]); p.z = pk2(x[4], x[5]); p.w = pk2(x[6], x[7]); return __builtin_bit_cast(s16x8, p); }
__device__ __forceinline__ void unpack8(u32x4 v, float (&x)[8]) { x[0] = bflo(v.x); x[1] = bfhi(v.x); x[2] = bflo(v.y); x[3] = bfhi(v.y); x[4] = bflo(v.z); x[5] = bfhi(v.z); x[6] = bflo(v.w); x[7] = bfhi(v.w); }

namespace pg8 {
typedef unsigned short bf16_t;
typedef short bf16x8 __attribute__((ext_vector_type(8)));
constexpr int BM = 256, BK = 64, HALF = 128, HTB = HALF * BK * 2, STAGE_BYTES = 8 * HTB, NXCD = 8, WGM = 8;
__device__ __forceinline__ int lds_byte(int r, int c) { const int st = (r >> 4) * 2 + (c >> 5), rr = r & 15, cc = c & 31, ob = rr * 64 + cc * 2; return st * 1024 + (ob ^ (((ob >> 9) & 1) << 5)); }
__device__ __forceinline__ void stage_rc(int b, int& R, int& C) { const int st = b / 1024, sb = b % 1024, swz = sb ^ (((sb >> 9) & 1) << 5); R = (st >> 1) * 16 + swz / 64; C = (st & 1) * 32 + (swz % 64) / 2; }
__device__ __forceinline__ int perm32(int rho) { const int n = rho >> 4, i = rho & 15; return 8 * (i >> 2) + 4 * n + (i & 3); }

struct Unit { int pm, pn, kind; };
struct Gemm { int lda, ldb, K; };
struct Sched {
    const char* A0; const char* B0; int nM0, nN0, nwg0;
    const char* A1; const char* B1; int nM1, nN1, nwg1;
    size_t tA, tB; int G, c;
    __device__ void init(const void* a0, const void* b0, int M0, int N0, const void* a1, const void* b1, int M1, int N1, int lda, int ldb, int G_, int c_) {
        A0 = (const char*)a0; B0 = (const char*)b0; nM0 = M0 / BM; nN0 = N0 / BM; nwg0 = nM0 * nN0;
        A1 = (const char*)a1; B1 = (const char*)b1; nM1 = M1 / BM; nN1 = N1 / BM; nwg1 = nM1 * nN1;
        tA = (size_t)BM * lda * 2; tB = (size_t)BM * ldb * 2; G = G_; c = c_;
    }
    __device__ __forceinline__ static void map(int wgid, int nwg, int nM, int nN, Unit& u) {
        { const int q = nwg / NXCD, r = nwg % NXCD, xcd = wgid % NXCD, off = wgid / NXCD; wgid = (xcd < r ? xcd * (q + 1) : r * (q + 1) + (xcd - r) * q) + off; }
        const int nig = WGM * nN, gid = wgid / nig, fm = gid * WGM, gsz = (nM - fm) < WGM ? (nM - fm) : WGM;
        u.pm = fm + ((wgid % nig) % gsz); u.pn = (wgid % nig) / gsz;
    }
    __device__ __forceinline__ bool next(int i, Unit& u) const {
        const long L = (long)i * G + c;
        if (L < nwg0) { map((int)L, nwg0, nM0, nN0, u); u.kind = 0; return true; }
        const long L1 = L - nwg0;
        if (L1 < nwg1) { map((int)L1, nwg1, nM1, nN1, u); u.kind = 1; return true; }
        return false;
    }
    __device__ __forceinline__ void ptrs(const Unit& u, const char*& a, const char*& b) const {
        if (u.kind == 0) { a = A0 + (size_t)u.pm * tA; b = B0 + (size_t)u.pn * tB; } else { a = A1 + (size_t)u.pm * tA; b = B1 + (size_t)u.pn * tB; }
    }
};

template <class Epi>
__device__ __forceinline__ void gemm_phase(LAS unsigned char* lds, const Gemm g, const Sched& S, const Epi& E, const int tid) {
    const int wid = __builtin_amdgcn_readfirstlane(tid >> 6), lane = tid & 63, wr = wid >> 2, wc = wid & 3, fr = lane & 15, fq = lane >> 4;
    const int K = g.K, nt = K / BK;
    unsigned voffA[2], voffB[2];
#pragma unroll
    for (int i = 0; i < 2; ++i) { int R, C; stage_rc(tid * 16 + i * 8192, R, C); const int Rb = Epi::PERM ? ((R & ~31) + perm32(R & 31)) : R;
        voffA[i] = (unsigned)(R * g.lda + C) * 2u; voffB[i] = (unsigned)(Rb * g.ldb + C) * 2u; }
    const size_t kstep = (size_t)(BK * 2);
    const size_t hA = (size_t)HALF * g.lda * 2, hB = (size_t)HALF * g.ldb * 2;
    const unsigned ldsw = (unsigned)wid * 1024u;
    const int aoff = lds_byte(wr * 64 + fr, fq * 8), boff = lds_byte(wc * 32 + fr, fq * 8);
#define PG8_SA(b, h) (((b) * 2 + (h)) * HTB)
#define PG8_SB(b, h) ((4 + (b) * 2 + (h)) * HTB)
#define PG8_STAGE(bufoff, gbase, voff) do { _Pragma("unroll") for (int _i = 0; _i < 2; ++_i) \
        __builtin_amdgcn_global_load_lds((const unsigned*)((const char*)(gbase) + (voff)[_i]), (LAS unsigned*)(lds + (bufoff) + ldsw + _i * 8192), 16, 0, 0); } while (0)
#define PG8_LDA(dst, b, h) do { _Pragma("unroll") for (int m = 0; m < 4; ++m) _Pragma("unroll") for (int k = 0; k < 2; ++k) dst[m][k] = *(const LAS bf16x8*)(lds + PG8_SA(b, h) + aoff + m * 2048 + k * 1024); } while (0)
#define PG8_LDB(dst, b, h) do { _Pragma("unroll") for (int n = 0; n < 2; ++n) _Pragma("unroll") for (int k = 0; k < 2; ++k) dst[n][k] = *(const LAS bf16x8*)(lds + PG8_SB(b, h) + boff + n * 2048 + k * 1024); } while (0)
#define PG8_MMA(ai, bj, At, Bt) do { __builtin_amdgcn_s_setprio(1); _Pragma("unroll") for (int m = 0; m < 4; ++m) _Pragma("unroll") for (int n = 0; n < 2; ++n) _Pragma("unroll") for (int k = 0; k < 2; ++k) \
        acc[ai][bj][m][n] = __builtin_amdgcn_mfma_f32_16x16x32_bf16(Bt[n][k], At[m][k], acc[ai][bj][m][n], 0, 0, 0); __builtin_amdgcn_s_setprio(0); } while (0)
#define PG8_WAIT_V(n) asm volatile("s_waitcnt vmcnt(" #n ")" ::: "memory")
#define PG8_WAIT_L(n) asm volatile("s_waitcnt lgkmcnt(" #n ")" ::: "memory")
#define PG8_BAR __builtin_amdgcn_s_barrier()
#define PG8_SCHED __builtin_amdgcn_sched_barrier(0)
    Unit cur, nxt; int ui = 0;
    if (!S.next(0, cur)) return;
    f32x4 acc[2][2][4][2];
#pragma unroll
    for (int a = 0; a < 2; ++a)
#pragma unroll
        for (int b = 0; b < 2; ++b)
#pragma unroll
            for (int m = 0; m < 4; ++m)
#pragma unroll
                for (int n = 0; n < 2; ++n) acc[a][b][m][n] = (f32x4){0.f, 0.f, 0.f, 0.f};
    bf16x8 At[4][2], B0[2][2], B1[2][2];
    const char* cA; const char* cB; S.ptrs(cur, cA, cB);
    PG8_STAGE(PG8_SB(0, 0), cB, voffB); PG8_STAGE(PG8_SB(0, 1), cB + hB, voffB); PG8_STAGE(PG8_SA(0, 0), cA, voffA); PG8_STAGE(PG8_SA(0, 1), cA + hA, voffA);
    if (wr == 1) PG8_BAR;
    PG8_WAIT_V(2); PG8_BAR;
    PG8_STAGE(PG8_SB(1, 0), cB + kstep, voffB); PG8_STAGE(PG8_SA(1, 0), cA + kstep, voffA); PG8_STAGE(PG8_SB(1, 1), cB + hB + kstep, voffB);
    PG8_WAIT_V(6); PG8_BAR;
    for (;;) {
        const bool has_next = S.next(ui + 1, nxt);
        const char* nA = cA; const char* nB = cB; if (has_next) S.ptrs(nxt, nA, nB);
        for (int t = 0; t < nt; t += 2) {
            const bool last = (t == nt - 2);
            const char* a1 = cA + (size_t)(t + 1) * kstep;
            const char* a2 = last ? nA : cA + (size_t)(t + 2) * kstep; const char* b2 = last ? nB : cB + (size_t)(t + 2) * kstep;
            const char* a3 = a2 + kstep; const char* b3 = b2 + kstep;
            PG8_LDB(B0, 0, 0); PG8_LDB(B1, 0, 1); PG8_SCHED; PG8_LDA(At, 0, 0); PG8_STAGE(PG8_SA(1, 1), a1 + hA, voffA);
            PG8_WAIT_V(8); PG8_WAIT_L(0); PG8_BAR; PG8_MMA(0, 0, At, B0); PG8_MMA(0, 1, At, B1); PG8_BAR; PG8_SCHED;
            PG8_LDA(At, 0, 1); PG8_STAGE(PG8_SB(0, 0), b2, voffB); PG8_STAGE(PG8_SB(0, 1), b2 + hB, voffB); PG8_STAGE(PG8_SA(0, 0), a2, voffA);
            PG8_WAIT_V(8); PG8_WAIT_L(0); PG8_BAR; PG8_MMA(1, 0, At, B0); PG8_MMA(1, 1, At, B1); PG8_BAR; PG8_SCHED;
            PG8_LDB(B0, 1, 0); PG8_LDB(B1, 1, 1); PG8_SCHED; PG8_LDA(At, 1, 0); PG8_STAGE(PG8_SA(0, 1), a2 + hA, voffA);
            PG8_WAIT_V(8); PG8_WAIT_L(0); PG8_BAR; PG8_MMA(0, 0, At, B0); PG8_MMA(0, 1, At, B1); PG8_BAR; PG8_SCHED;
            PG8_LDA(At, 1, 1); PG8_STAGE(PG8_SB(1, 0), b3, voffB); PG8_STAGE(PG8_SB(1, 1), b3 + hB, voffB); PG8_STAGE(PG8_SA(1, 0), a3, voffA);
            PG8_WAIT_V(8); PG8_WAIT_L(0); PG8_BAR; PG8_MMA(1, 0, At, B0); PG8_MMA(1, 1, At, B1); PG8_BAR; PG8_SCHED;
        }
        if (wr == 0) PG8_BAR;
        E(acc, cur, wr, wc, fr, fq);
        if (!has_next) break;
#pragma unroll
        for (int a = 0; a < 2; ++a)
#pragma unroll
            for (int b = 0; b < 2; ++b)
#pragma unroll
                for (int m = 0; m < 4; ++m)
#pragma unroll
                    for (int n = 0; n < 2; ++n) acc[a][b][m][n] = (f32x4){0.f, 0.f, 0.f, 0.f};
        cur = nxt; cA = nA; cB = nB; ++ui;
        if (wr == 1) PG8_BAR;
    }
    PG8_WAIT_V(0);
    PG8_BAR;
#undef PG8_SA
#undef PG8_SB
#undef PG8_STAGE
#undef PG8_LDA
#undef PG8_LDB
#undef PG8_MMA
#undef PG8_WAIT_V
#undef PG8_WAIT_L
#undef PG8_BAR
#undef PG8_SCHED
}

struct EpiIn {
    static constexpr bool PERM = true;
    bf16* U; bf16* KVt; bf16* halo;
    __device__ __forceinline__ void operator()(const f32x4 (&acc)[2][2][4][2], const Unit& u, int wr, int wc, int fr, int fq) const {
        bf16* base = u.kind == 0 ? U : KVt; const size_t ldc = u.kind == 0 ? (size_t)UW : (size_t)MT;
        const int row0 = u.pm * BM + wr * 64 + fr, col0 = u.pn * BM + wc * 32 + 8 * fq;
#pragma unroll
        for (int ai = 0; ai < 2; ++ai)
#pragma unroll
            for (int m = 0; m < 4; ++m) { bf16* rowp = base + (size_t)(row0 + ai * HALF + m * 16) * ldc + col0;
#pragma unroll
                for (int bj = 0; bj < 2; ++bj) { const f32x4 v0 = acc[ai][bj][m][0], v1 = acc[ai][bj][m][1];
                    u32x4 w; w.x = pk2(v0[0], v0[1]); w.y = pk2(v0[2], v0[3]); w.z = pk2(v1[0], v1[1]); w.w = pk2(v1[2], v1[3]);
                    *(u32x4*)(rowp + bj * HALF) = w;
                    if (u.kind == 0 && (u.pn >> 2) == 1 && fr >= 13 && (m & 1)) {
                        const int row = row0 + ai * HALF + m * 16;
                        int hidx = -1;
                        if (row >= MP) hidx = 512 + ((row - MP) >> 5); else if (m == 3) hidx = row >> 6;
                        if (hidx >= 0) *(u32x4*)(halo + ((size_t)hidx * 3 + (fr - 13)) * 1024 + (col0 - 1024) + bj * HALF) = w; } } }
    }
};
struct EpiGate {
    static constexpr bool PERM = true;
    const bf16* gate; const bf16* add; bf16* out; bool st;
    __device__ __forceinline__ void operator()(const f32x4 (&acc)[2][2][4][2], const Unit& u, int wr, int wc, int fr, int fq) const {
        const int row0 = u.pm * BM + wr * 64 + fr, col0 = u.pn * BM + wc * 32 + 8 * fq;
#pragma unroll
        for (int ai = 0; ai < 2; ++ai) {
            u32x4 gq[4][2], aq[4][2];
#pragma unroll
            for (int m = 0; m < 4; ++m)
#pragma unroll
                for (int bj = 0; bj < 2; ++bj) { const size_t off = (size_t)(row0 + ai * HALF + m * 16) * UW + col0 + bj * HALF;
                    gq[m][bj] = *(const u32x4*)(gate + off); if (add) aq[m][bj] = *(const u32x4*)(add + off); else aq[m][bj] = (u32x4){0u, 0u, 0u, 0u}; }
#pragma unroll
            for (int m = 0; m < 4; ++m)
#pragma unroll
                for (int bj = 0; bj < 2; ++bj) { const size_t off = (size_t)(row0 + ai * HALF + m * 16) * UW + col0 + bj * HALF;
                    const f32x4 v0 = acc[ai][bj][m][0], v1 = acc[ai][bj][m][1];
                    float gv[8], av[8]; unpack8(gq[m][bj], gv); unpack8(aq[m][bj], av);
                    float o[8];
#pragma unroll
                    for (int e = 0; e < 4; ++e) { o[e] = av[e] + sigmoidf_(gv[e]) * v0[e]; o[4 + e] = av[4 + e] + sigmoidf_(gv[4 + e]) * v1[e]; }
                    u32x4 w; w.x = pk2(o[0], o[1]); w.y = pk2(o[2], o[3]); w.z = pk2(o[4], o[5]); w.w = pk2(o[6], o[7]);
                    if (st) *(u32x4*)(out + off) = w; }
            asm volatile("" ::: "memory");
        }
    }
};
struct EpiRes {
    static constexpr bool PERM = true;
    const float* xp; const float* xs; float* X; const float* gt; bool st;
    __device__ __forceinline__ void operator()(const f32x4 (&acc)[2][2][4][2], const Unit& u, int wr, int wc, int fr, int fq) const {
        const int col0 = u.pn * BM + wc * 32 + 8 * fq;
        const float* g = gt + (size_t)((u.pm * BM) >> 13) * 6144 + col0;
        const float* src = (xp ? xp : X) + (size_t)(u.pm * BM + wr * 64 + fr) * DM + col0;
        float* dst = X + (size_t)(u.pm * BM + wr * 64 + fr) * DM + col0;
        f32x4 gv[2][2];
#pragma unroll
        for (int bj = 0; bj < 2; ++bj)
#pragma unroll
            for (int n = 0; n < 2; ++n) gv[bj][n] = *(const f32x4*)(g + bj * HALF + 4 * n);
#pragma unroll
        for (int ai = 0; ai < 2; ++ai)
#pragma unroll
          for (int mp = 0; mp < 2; ++mp) {
            f32x4 xv[2][2][2];
#pragma unroll
            for (int mm = 0; mm < 2; ++mm)
#pragma unroll
                for (int bj = 0; bj < 2; ++bj)
#pragma unroll
                    for (int n = 0; n < 2; ++n) xv[mm][bj][n] = *(const f32x4*)(src + (size_t)(ai * HALF + (2 * mp + mm) * 16) * DM + bj * HALF + 4 * n);
#pragma unroll
            for (int mm = 0; mm < 2; ++mm)
#pragma unroll
                for (int bj = 0; bj < 2; ++bj)
#pragma unroll
                    for (int n = 0; n < 2; ++n) { const f32x4 o = xv[mm][bj][n] + gv[bj][n] * acc[ai][bj][2 * mp + mm][n];
                        if (st) *(f32x4*)(dst + (size_t)(ai * HALF + (2 * mp + mm) * 16) * DM + bj * HALF + 4 * n) = o; }
            asm volatile("" ::: "memory");
        }
    }
};
struct EpiSwiglu {
    static constexpr bool PERM = true;
    bf16* act;
    __device__ __forceinline__ void operator()(const f32x4 (&acc)[2][2][4][2], const Unit& u, int wr, int wc, int fr, int fq) const {
        const int row0 = u.pm * BM + wr * 64 + fr, col0 = u.pn * HALF + wc * 32 + 8 * fq;
#pragma unroll
        for (int ai = 0; ai < 2; ++ai)
#pragma unroll
            for (int m = 0; m < 4; ++m) { bf16* rowp = act + (size_t)(row0 + ai * HALF + m * 16) * DFF + col0;
                float o[8];
#pragma unroll
                for (int n = 0; n < 2; ++n)
#pragma unroll
                    for (int e = 0; e < 4; ++e) o[4 * n + e] = siluf_(acc[ai][0][m][n][e]) * acc[ai][1][m][n][e];
                u32x4 w; w.x = pk2(o[0], o[1]); w.y = pk2(o[2], o[3]); w.z = pk2(o[4], o[5]); w.w = pk2(o[6], o[7]);
                *(u32x4*)rowp = w; }
    }
};
}


#define XB_TMO      128
#define XB_XCNT(j)  (256  + 64 * (j))
#define XB_XSUB(j)  (1280 + 64 * (j))
#define XB_XGEN(j)  (2304 + 64 * (j))
#define XB_TOP      3328
#define XB_TOPGEN   3392
#define XCD_BAR_WORDS 3456
#define XB_SPIN_CAP (1u << 22)
__device__ __forceinline__ unsigned xb_ld(unsigned* p)              { return __hip_atomic_load(p, __ATOMIC_RELAXED, __HIP_MEMORY_SCOPE_AGENT); }
__device__ __forceinline__ unsigned xb_add(unsigned* p, unsigned v) { return __hip_atomic_fetch_add(p, v, __ATOMIC_RELAXED, __HIP_MEMORY_SCOPE_AGENT); }
__device__ __forceinline__ unsigned xb_xcc_id() { return (unsigned)__builtin_amdgcn_s_getreg((3 << 11) | 20) & 0xFu; }
#define XB_SPIN(cond, bar) do { unsigned _sp = 0; while (cond) { __builtin_amdgcn_s_sleep(1); \
    if ((++_sp & 255u) == 0u) { if (xb_ld(&(bar)[XB_TMO])) break; if (_sp > XB_SPIN_CAP) { atomicAdd(&(bar)[XB_TMO], 1u); break; } } } } while (0)
struct XcdBarrier { unsigned* bar; unsigned x; volatile LAS unsigned* st; };
__device__ __forceinline__ XcdBarrier xcd_barrier_post(unsigned* bar, volatile LAS unsigned* st) {
    XcdBarrier b; b.bar = bar; b.x = xb_xcc_id(); b.st = st;
    if (threadIdx.x == 0) (void)xb_add(&bar[XB_XCNT(b.x)], 1u);
    return b;
}
__device__ __forceinline__ void xcd_barrier_complete(unsigned* bar, unsigned x, unsigned& nloc, unsigned& nx) {
    const unsigned G = gridDim.x * gridDim.y * gridDim.z;
    unsigned sum, cnt, mine, sp = 0u;
    for (;;) {
        sum = 0u; cnt = 0u; mine = 0u;
#pragma unroll
        for (unsigned j = 0; j < 16; ++j) { const unsigned c = xb_ld(&bar[XB_XCNT(j)]); sum += c; cnt += (c > 0u) ? 1u : 0u; mine = (j == x) ? c : mine; }
        if (sum == G) break;
        __builtin_amdgcn_s_sleep(1);
        if ((++sp & 255u) == 0u) { if (xb_ld(&bar[XB_TMO])) break; if (sp > XB_SPIN_CAP) { atomicAdd(&bar[XB_TMO], 1u); break; } }
    }
    nloc = mine > 0u ? mine : 1u; nx = cnt > 0u ? cnt : 1u;
}
__device__ __forceinline__ void xcd_barrier(const XcdBarrier& b) {
    asm volatile("s_waitcnt vmcnt(0)" ::: "memory");
    __syncthreads();
    if (threadIdx.x == 0) {
        unsigned* bar = b.bar;
        __builtin_amdgcn_s_waitcnt(0);
        unsigned nloc = b.st[0], nx = b.st[1];
        if (nloc == 0u) { xcd_barrier_complete(bar, b.x, nloc, nx); b.st[0] = nloc; b.st[1] = nx; }
        const unsigned old = xb_add(&bar[XB_XSUB(b.x)], 1u);
        const unsigned gen = old / nloc;
        if (old + 1u == (gen + 1u) * nloc) {
            __builtin_amdgcn_fence(__ATOMIC_RELEASE, "agent");
            asm volatile("s_waitcnt vmcnt(0)" ::: "memory");
            const unsigned og = xb_add(&bar[XB_TOP], 1u);
            const unsigned tg = og / nx;
            if (og + 1u == (tg + 1u) * nx) xb_add(&bar[XB_TOPGEN], 1u);
            else XB_SPIN(xb_ld(&bar[XB_TOPGEN]) == tg, bar);
            __builtin_amdgcn_fence(__ATOMIC_ACQUIRE, "agent");
            xb_add(&bar[XB_XGEN(b.x)], 1u);
            asm volatile("s_waitcnt vmcnt(0)" ::: "memory");
        } else {
            XB_SPIN(xb_ld(&bar[XB_XGEN(b.x)]) == gen, bar);
            __builtin_amdgcn_fence(__ATOMIC_ACQUIRE, "agent");
            asm volatile("s_waitcnt vmcnt(0)" ::: "memory");
        }
    }
    __syncthreads();
}

struct Args {
    const float* in[26]; float* out; unsigned char* ws;
};

struct Ctx {
    const float* const* in; float* out; unsigned char* ws;
    int tid, lane, wave, G, bid;
    __device__ __forceinline__ bf16* U() const { return (bf16*)(ws + WS_U); }
    __device__ __forceinline__ bf16* KVt() const { return (bf16*)(ws + WS_KVT); }
    __device__ __forceinline__ bf16* XN() const { return (bf16*)(ws + WS_XN); }
    __device__ __forceinline__ bf16* ACT() const { return (bf16*)(ws + WS_U); }
    __device__ __forceinline__ bf16* DC() const { return (bf16*)(ws + WS_XN); }
    __device__ __forceinline__ bf16* DCS() const { return (bf16*)(ws + WS_DCS); }
    __device__ __forceinline__ unsigned char* W() const { return ws + WS_W; }
    __device__ __forceinline__ bf16* HALO() const { return (bf16*)(ws + WS_MODP); }
    __device__ __forceinline__ float* MOD(int l) const { return (float*)(ws + WS_MODP + (4u << 20) + (size_t)l * (1u << 20)); }
    __device__ __forceinline__ float* GATES() const { return (float*)(ws + WS_GATES); }
    __device__ __forceinline__ float* DN() const { return (float*)(ws + WS_DN); }
    __device__ __forceinline__ float* MBM() const { return (float*)(ws + WS_MB); }
    __device__ __forceinline__ float* MBB() const { return (float*)(ws + WS_MB) + (NSLOT_P + NSLOT_S); }
    __device__ __forceinline__ float* MST() const { return (float*)(ws + WS_MB) + 2 * (NSLOT_P + NSLOT_S); }
};

__device__ __forceinline__ void transpose_item(const float* W, int ldw, int K, bf16* WT, int dst_row0, int src_col0, int k0, LAS float* scr, int lane) {
#pragma unroll 8
    for (int i = 0; i < 32; ++i) { const int kk = 2 * i + (lane >> 5); scr[kk * 33 + (lane & 31)] = W[(size_t)(k0 + kk) * ldw + src_col0 + (lane & 31)]; }
    LDS_WAIT();
    const int c = lane & 7;
#pragma unroll
    for (int j = 0; j < 4; ++j) { const int n = (lane >> 3) + 8 * j; const LAS float* s = scr + (8 * c) * 33 + n;
        u32x4 o; o.x = pk2(s[0 * 33], s[1 * 33]); o.y = pk2(s[2 * 33], s[3 * 33]); o.z = pk2(s[4 * 33], s[5 * 33]); o.w = pk2(s[6 * 33], s[7 * 33]);
        *(u32x4*)(WT + (size_t)(dst_row0 + n) * K + k0 + 8 * c) = o; }
    LDS_WAIT();
}
constexpr int CV_IN = 16 * (NWIN / 32), CV_BA = 8 * 32, CV_OUT = 16 * 32, CV_GU = 16 * (2 * DFF / 32), CV_DN = (DFF / 64) * 32;
constexpr int CV_SPLIT = CV_IN + 2 * CV_BA + CV_OUT, CV_ALL = CV_SPLIT + CV_GU + CV_DN;
__device__ __forceinline__ int win_src_col(int n) {
    if (n < 1024) return n;
    if (n < 1536) return 1536 + (n - 1024);
    if (n < 2048) return 2048 + (n - 1536);
    if (n < 2560) return 3072 + (n - 2048);
    if (n < 3584) return 3592 + (n - 2560);
    if (n < 4608) return 4616 + (n - 3584);
    if (n < 5120) return 1024 + (n - 4608);
    if (n < 5632) return 2560 + (n - 5120);
    return 2048 + (n - 5632);
}
__device__ __forceinline__ void phase_convert(Ctx& C, int l, LAS unsigned char* lds, const int it_lo, const int it_hi, const int nmod) {
    LAS float* scr = (LAS float*)(lds + 32768 + C.wave * 8704);
    const int gw = C.bid * 8 + C.wave, NGW = C.G * 8;
    const float* w_in = C.in[13] + (size_t)l * 1024 * INW; const float* w_ba = C.in[19] + (size_t)l * 512 * 1024; const float* w_bm = C.in[20] + (size_t)l * 512 * 1024;
    const float* w_out = C.in[21] + (size_t)l * 1024 * 1024; const float* w_gu = C.in[23] + (size_t)l * 1024 * 2 * DFF; const float* w_dn = C.in[24] + (size_t)l * DFF * 1024;
    constexpr int I_IN = CV_IN, I_BA = CV_BA, I_OUT = CV_OUT, I_GU = CV_GU, I_DN = CV_DN;
    constexpr int NIT = CV_ALL;
    for (int it = it_lo + gw; it < (it_hi < NIT ? it_hi : NIT); it += NGW) {
        int r = it;
        if (r < I_IN) { const int nb = r % (NWIN / 32), kb = r / (NWIN / 32); transpose_item(w_in, INW, 1024, (bf16*)(C.W() + W_IN), nb * 32, win_src_col(nb * 32), kb * 64, scr, C.lane); continue; } r -= I_IN;
        if (r < I_BA) { const int nb = r % 32, kb = r / 32; transpose_item(w_ba, 1024, 512, (bf16*)(C.W() + W_BA), nb * 32, nb * 32, kb * 64, scr, C.lane); continue; } r -= I_BA;
        if (r < I_BA) { const int nb = r % 32, kb = r / 32; transpose_item(w_bm, 1024, 512, (bf16*)(C.W() + W_BM), nb * 32, nb * 32, kb * 64, scr, C.lane); continue; } r -= I_BA;
        if (r < I_OUT) { const int nb = r % 32, kb = r / 32; transpose_item(w_out, 1024, 1024, (bf16*)(C.W() + W_OUT), nb * 32, nb * 32, kb * 64, scr, C.lane); continue; } r -= I_OUT;
        if (r < I_GU) { const int nb = r % (2 * DFF / 32), kb = r / (2 * DFF / 32); const int n0 = nb * 32, t = n0 / 256, hh = (n0 % 256) / 128, j = n0 % 128;
            transpose_item(w_gu, 2 * DFF, 1024, (bf16*)(C.W() + W_GU), n0, hh * DFF + 128 * t + j, kb * 64, scr, C.lane); continue; } r -= I_GU;
        { const int nb = r % 32, kb = r / 32; transpose_item(w_dn, 1024, DFF, (bf16*)(C.W() + W_DN), nb * 32, nb * 32, kb * 64, scr, C.lane); }
    }
    if (nmod == 0) return;
    __syncthreads();

    LAS float* sl = (LAS float*)lds;
    LAS float* red = (LAS float*)(lds + 73728);
    for (int task2 = C.bid; task2 < 96 * nmod; task2 += C.G) {
        const int ml = task2 / 96, task = task2 % 96;
        const float* w_ada = C.in[10] + (size_t)ml * 1024 * 6144; const float* b_ada = C.in[11] + (size_t)ml * 6144;
        const int col = C.tid & 63, ksl = C.tid >> 6, n = task * 64 + col;
        for (int pass = 0; pass < 2; ++pass) {
            for (int i = C.tid; i < 18 * 1024; i += 512) { const int cb = pass * 18 + (i >> 10), k = i & 1023; const float cv = cb < 4 ? C.in[8][cb * 1024 + k] : C.in[9][(cb - 4) * 1024 + k]; sl[i] = siluf_(cv); }
            __syncthreads();
            float a[18];
#pragma unroll
            for (int cb = 0; cb < 18; ++cb) a[cb] = 0.f;
#pragma unroll 1
            for (int kb = 0; kb < 128; kb += 16) { float wv[16];
#pragma unroll
                for (int j = 0; j < 16; ++j) wv[j] = w_ada[(size_t)(ksl * 128 + kb + j) * 6144 + n];
#pragma unroll
                for (int j = 0; j < 16; ++j)
#pragma unroll
                    for (int cb = 0; cb < 18; ++cb) a[cb] += sl[cb * 1024 + ksl * 128 + kb + j] * wv[j]; }
#pragma unroll
            for (int cb = 0; cb < 18; ++cb) red[(ksl * 18 + cb) * 64 + col] = a[cb];
            __syncthreads();
            for (int i = C.tid; i < 18 * 64; i += 512) { const int cb = i >> 6, cc = i & 63; float s = b_ada[task * 64 + cc];
#pragma unroll
                for (int q = 0; q < 8; ++q) s += red[(q * 18 + cb) * 64 + cc];
                C.MOD(ml)[(size_t)(pass * 18 + cb) * 6144 + task * 64 + cc] = s; }
            __syncthreads();
        }
    }
}

template <bool GATES, bool FINAL>
__device__ __forceinline__ void phase_norm(Ctx& C, int l, const float* xp, const float* xs, const float* gvec, int k_sh, int k_sc, LAS unsigned char* lds) {
    LAS float* wgl = (LAS float*)lds;
    if (GATES) {
        const float* w_in = C.in[13] + (size_t)l * 1024 * INW;
        for (int i = C.tid; i < 8192; i += 512) { const int j = i & 7, k = i >> 3; wgl[j * 1024 + k] = w_in[(size_t)k * INW + 3584 + j]; }
        __syncthreads();
    }
    const int gw = C.bid * 8 + C.wave, NGW = C.G * 8, lane = C.lane;
    float* X = C.out;
    constexpr int NR = GATES ? 2 : 4;
    for (int k0 = 0; gw + k0 * NGW < MT; k0 += NR) {
        f32x4 v[NR][4]; float rstd[NR];
#pragma unroll
        for (int q = 0; q < NR; ++q) { int row = gw + (k0 + q) * NGW; row = row < MT ? row : gw;
            const float* xr = xp ? (row < MP ? xp + (size_t)row * DM : xs + (size_t)(row - MP) * DM) : X + (size_t)row * DM;
#pragma unroll
            for (int j = 0; j < 4; ++j) v[q][j] = *(const f32x4*)(xr + lane * 4 + 256 * j); }
#pragma unroll
        for (int q = 0; q < NR; ++q) { float ss = 0.f;
#pragma unroll
            for (int j = 0; j < 4; ++j) ss += (v[q][j].x * v[q][j].x + v[q][j].y * v[q][j].y) + (v[q][j].z * v[q][j].z + v[q][j].w * v[q][j].w);
            rstd[q] = rsqrtf(wave_sum(ss) * (1.f / DM) + EPS); }
#pragma unroll
        for (int q = 0; q < NR; ++q) { const int row = gw + (k0 + q) * NGW;
            if (row >= MT) continue;
            if (FINAL) {
#pragma unroll
                for (int j = 0; j < 4; ++j) { const f32x4 gv = *(const f32x4*)(gvec + lane * 4 + 256 * j); *(f32x4*)(X + (size_t)row * DM + lane * 4 + 256 * j) = v[q][j] * rstd[q] * gv; }
                continue;
            }
            const int cb = row < MP ? (row >> 13) : 4 + ((row - MP) >> 5);
            const float* mod = C.MOD(l) + (size_t)cb * 6144;
            float ga[8];
#pragma unroll
            for (int e = 0; e < 8; ++e) ga[e] = 0.f;
#pragma unroll
            for (int j = 0; j < 4; ++j) { const int c = lane * 4 + 256 * j;
                const f32x4 gv = *(const f32x4*)(gvec + c), sc = *(const f32x4*)(mod + k_sc * 1024 + c), sh = *(const f32x4*)(mod + k_sh * 1024 + c);
                const f32x4 h = v[q][j] * rstd[q] * gv * (sc + 1.f) + sh;
                u32x2 w; w.x = pk2(h.x, h.y); w.y = pk2(h.z, h.w);
                *(u32x2*)(C.XN() + (size_t)row * DM + c) = w;
                if (GATES) {
#pragma unroll
                    for (int e = 0; e < 8; ++e) { const f32x4 wv = *(const LAS f32x4*)(wgl + e * 1024 + c); ga[e] += (h.x * wv.x + h.y * wv.y) + (h.z * wv.z + h.w * wv.w); }
                }
            }
            if (GATES) {
#pragma unroll
                for (int e = 0; e < 8; ++e) ga[e] = wave_sum(ga[e]);
                float mine = ga[0];
#pragma unroll
                for (int e = 1; e < 8; ++e) mine = (lane == e) ? ga[e] : mine;
                if (lane < 8) { float z = mine + C.in[14][l * 8 + lane];
                    if (lane >= 4) z = fminf(z, 0.f) - __builtin_amdgcn_logf(1.f + fexp(-fabsf(z))) * 0.6931471805599453f;
                    C.GATES()[(size_t)row * 8 + lane] = z; }
            }
        }
    }
}

template <bool SAMPLE>
__device__ __forceinline__ void attn_task(Ctx& C, int l, int unit, int h, const LAS float* biasl, LAS s16x8* qfl, const bool st) {
    constexpr int NQB = SAMPLE ? 1 : 2;
    const int lane = C.lane, r = lane & 31, hi = lane >> 5;
    const int rp = (r & 19) | ((r & 4) << 1) | ((r & 8) >> 1);
    const int b = SAMPLE ? unit : unit / NPC, c = SAMPLE ? 0 : unit % NPC;
    const size_t grow0 = SAMPLE ? (size_t)MP + (size_t)unit * TS : (size_t)b * SEQ + (size_t)c * 64;
    const int cc0 = SAMPLE ? 0 : (c > 8 ? c - 8 : 0);
    const int ntile = SAMPLE ? 17 : 2 * (c - cc0 + 1);
    const bf16* U = C.U(); const bf16* KVt = C.KVt();
    const float* cache_k = C.in[2] + ((size_t)(l * NBD + b) * 512) * 512; const float* cache_v = C.in[3] + ((size_t)(l * NBD + b) * 512) * 512;
    const LAS float* bl = biasl + h * 320;
    { s16x8 tq[NQB][4];
#pragma unroll
      for (int qb = 0; qb < NQB; ++qb)
#pragma unroll
        for (int ks = 0; ks < 4; ++ks) tq[qb][ks] = *(const s16x8*)(U + (grow0 + 32 * qb + r) * UW + C_QA + h * 64 + 16 * ks + 8 * hi);
#pragma unroll
      for (int qb = 0; qb < NQB; ++qb)
#pragma unroll
        for (int ks = 0; ks < 4; ++ks) qfl[(qb * 4 + ks) * 64 + lane] = tq[qb][ks];
    }
    LDS_WAIT();
    f32x16 O[NQB][2]; float mrun[NQB], lsum[NQB];
#pragma unroll
    for (int qb = 0; qb < NQB; ++qb) { mrun[qb] = -1e30f; lsum[qb] = 0.f;
#pragma unroll
        for (int db = 0; db < 2; ++db)
#pragma unroll
            for (int i = 0; i < 16; ++i) O[qb][db][i] = 0.f; }
    s16x8 Kc[4], Vc[2][2], Kn[4], Vn[2][2];
    auto load_k = [&](int t, s16x8 (&Kf)[4]) {
        if (!SAMPLE || t == 16) {
            const size_t krow = SAMPLE ? grow0 : (size_t)b * SEQ + (size_t)(cc0 + (t >> 1)) * 64 + 32 * (t & 1);
            const bf16* kp = U + (krow + rp) * UW + C_KA + h * 64 + 8 * hi;
#pragma unroll
            for (int ks = 0; ks < 4; ++ks) Kf[ks] = *(const s16x8*)(kp + 16 * ks);
        } else {
            const float* kp = cache_k + (size_t)(t * 32 + rp) * 512 + h * 64 + 8 * hi;
#pragma unroll
            for (int ks = 0; ks < 4; ++ks) { const f32x4 a = *(const f32x4*)(kp + 16 * ks), bq = *(const f32x4*)(kp + 16 * ks + 4);
                u32x4 w; w.x = pk2(a.x, a.y); w.y = pk2(a.z, a.w); w.z = pk2(bq.x, bq.y); w.w = pk2(bq.z, bq.w); Kf[ks] = __builtin_bit_cast(s16x8, w); }
        }
    };
    auto load_v = [&](int t, s16x8 (&Vf)[2][2]) {
        if (!SAMPLE || t == 16) {
            const size_t krow = SAMPLE ? grow0 : (size_t)b * SEQ + (size_t)(cc0 + (t >> 1)) * 64 + 32 * (t & 1);
#pragma unroll
            for (int db = 0; db < 2; ++db)
#pragma unroll
                for (int s2 = 0; s2 < 2; ++s2) Vf[db][s2] = *(const s16x8*)(KVt + (size_t)(R_VA + h * 64 + 32 * db + r) * MT + krow + 16 * s2 + 8 * hi);
        } else {
#pragma unroll
            for (int db = 0; db < 2; ++db)
#pragma unroll
                for (int s2 = 0; s2 < 2; ++s2) { const float* vp = cache_v + (size_t)(t * 32 + 16 * s2 + 8 * hi) * 512 + h * 64 + 32 * db + r;
                    float x[8];
#pragma unroll
                    for (int e = 0; e < 8; ++e) x[e] = vp[(size_t)e * 512];
                    Vf[db][s2] = pack8(x); }
        }
    };
    load_k(0, Kc); load_v(0, Vc);
    for (int t = 0; t < ntile; ++t) {
        { const int tn = (t + 1 < ntile) ? t + 1 : t; load_k(tn, Kn); load_v(tn, Vn); }
        const int dbase = SAMPLE ? (512 - 32 * t) : ((c - (cc0 + (t >> 1))) * 64 - 32 * (t & 1));
#pragma unroll
        for (int qb = 0; qb < NQB; ++qb) {
            f32x16 S;
#pragma unroll
            for (int i = 0; i < 16; ++i) S[i] = 0.f;
#pragma unroll
            for (int ks = 0; ks < 4; ++ks) S = MFMA32(Kc[ks], qfl[(qb * 4 + ks) * 64 + lane], S);
            const int d0 = dbase + 32 * qb + r - 8 * hi;
            const int dq = dbase + 32 * qb;
            constexpr float SC = 0.125f * LOG2E;
#define KO_(i) (16 * ((i) >> 3) + 4 * (((i) >> 2) & 1) + ((i) & 3))
            float tmax = -1e30f;
            if (dq - 31 >= 256) {
                const float bv = bl[319];
#pragma unroll
                for (int i = 0; i < 16; ++i) { S[i] = S[i] * SC + bv; tmax = fmaxf(tmax, S[i]); }
            } else if (dq + 31 <= 256 && dq - 31 >= -63) {
                const LAS float* bp = bl + (d0 + 63 - 23);
#pragma unroll
                for (int i = 0; i < 16; ++i) { S[i] = S[i] * SC + bp[23 - KO_(i)]; tmax = fmaxf(tmax, S[i]); }
            } else {
#pragma unroll
                for (int i = 0; i < 16; ++i) { int d = d0 - KO_(i); d = d < -63 ? -63 : (d > 256 ? 256 : d);
                    S[i] = S[i] * SC + bl[d + 63]; tmax = fmaxf(tmax, S[i]); }
            }
#undef KO_
            tmax = fmaxf(tmax, __shfl_xor(tmax, 32));
            if (__any(tmax > mrun[qb] + 8.f)) {
                const float mnew = fmaxf(mrun[qb], tmax), alpha = __builtin_amdgcn_exp2f(mrun[qb] - mnew);
                mrun[qb] = mnew; lsum[qb] *= alpha;
#pragma unroll
                for (int db = 0; db < 2; ++db)
#pragma unroll
                    for (int i = 0; i < 16; ++i) O[qb][db][i] *= alpha;
            }
            const float mref = mrun[qb];
            float ps = 0.f;
#pragma unroll
            for (int i = 0; i < 16; ++i) { S[i] = __builtin_amdgcn_exp2f(S[i] - mref); ps += S[i]; }
            lsum[qb] += ps;
#pragma unroll
            for (int s2 = 0; s2 < 2; ++s2) { u32x4 w; w.x = pk2(S[8 * s2], S[8 * s2 + 1]); w.y = pk2(S[8 * s2 + 2], S[8 * s2 + 3]); w.z = pk2(S[8 * s2 + 4], S[8 * s2 + 5]); w.w = pk2(S[8 * s2 + 6], S[8 * s2 + 7]);
                const s16x8 pf = __builtin_bit_cast(s16x8, w);
#pragma unroll
                for (int db = 0; db < 2; ++db) O[qb][db] = MFMA32(Vc[db][s2], pf, O[qb][db]); }
        }
#pragma unroll
        for (int ks = 0; ks < 4; ++ks) Kc[ks] = Kn[ks];
#pragma unroll
        for (int db = 0; db < 2; ++db)
#pragma unroll
            for (int s2 = 0; s2 < 2; ++s2) Vc[db][s2] = Vn[db][s2];
    }
    bf16* Uo = C.U();
#pragma unroll
    for (int qb = 0; qb < NQB; ++qb) {
        const float lt = lsum[qb] + __shfl_xor(lsum[qb], 32), inv = __builtin_amdgcn_rcpf(lt);
        bf16* orow = Uo + (grow0 + 32 * qb + r) * UW + C_QA + h * 64;
#pragma unroll
        for (int db = 0; db < 2; ++db)
#pragma unroll
            for (int i4 = 0; i4 < 4; ++i4) { u32x2 w; w.x = pk2(O[qb][db][4 * i4] * inv, O[qb][db][4 * i4 + 1] * inv); w.y = pk2(O[qb][db][4 * i4 + 2] * inv, O[qb][db][4 * i4 + 3] * inv);
                if (st) *(u32x2*)(orow + 32 * db + 8 * i4 + 4 * hi) = w; }
    }
    LDS_WAIT();
}


__device__ __forceinline__ void attn_sample_wg(Ctx& C, int l, int bd, int h, const LAS float* biasl, LAS float* partO, LAS float* partML, const bool st) {
    const int lane = C.lane, r = lane & 31, hi = lane >> 5, w = C.wave;
    const int rp = (r & 19) | ((r & 4) << 1) | ((r & 8) >> 1);
    const size_t grow0 = (size_t)MP + (size_t)bd * TS;
    const bf16* U = C.U(); const bf16* KVt = C.KVt();
    const float* cache_k = C.in[2] + ((size_t)(l * NBD + bd) * 512) * 512; const float* cache_v = C.in[3] + ((size_t)(l * NBD + bd) * 512) * 512;
    const LAS float* bl = biasl + h * 320;
    s16x8 Qf[4];
#pragma unroll
    for (int ks = 0; ks < 4; ++ks) Qf[ks] = *(const s16x8*)(U + (grow0 + r) * UW + C_QA + h * 64 + 16 * ks + 8 * hi);
    f32x16 O[2]; float mrun = -1e30f, lsum = 0.f;
#pragma unroll
    for (int db = 0; db < 2; ++db)
#pragma unroll
        for (int i = 0; i < 16; ++i) O[db][i] = 0.f;
    for (int t = w; t < 17; t += 8) {
        s16x8 Kf[4], Vf[2][2];
        if (t == 16) {
            const bf16* kp = U + (grow0 + rp) * UW + C_KA + h * 64 + 8 * hi;
#pragma unroll
            for (int ks = 0; ks < 4; ++ks) Kf[ks] = *(const s16x8*)(kp + 16 * ks);
#pragma unroll
            for (int db = 0; db < 2; ++db)
#pragma unroll
                for (int s2 = 0; s2 < 2; ++s2) Vf[db][s2] = *(const s16x8*)(KVt + (size_t)(R_VA + h * 64 + 32 * db + r) * MT + grow0 + 16 * s2 + 8 * hi);
        } else {
            const float* kp = cache_k + (size_t)(t * 32 + rp) * 512 + h * 64 + 8 * hi;
            f32x4 ka[4], kb[4]; float vx[2][2][8];
#pragma unroll
            for (int ks = 0; ks < 4; ++ks) { ka[ks] = *(const f32x4*)(kp + 16 * ks); kb[ks] = *(const f32x4*)(kp + 16 * ks + 4); }
#pragma unroll
            for (int db = 0; db < 2; ++db)
#pragma unroll
                for (int s2 = 0; s2 < 2; ++s2) { const float* vp = cache_v + (size_t)(t * 32 + 16 * s2 + 8 * hi) * 512 + h * 64 + 32 * db + r;
#pragma unroll
                    for (int e = 0; e < 8; ++e) vx[db][s2][e] = vp[(size_t)e * 512]; }
#pragma unroll
            for (int ks = 0; ks < 4; ++ks) { u32x4 ww; ww.x = pk2(ka[ks].x, ka[ks].y); ww.y = pk2(ka[ks].z, ka[ks].w); ww.z = pk2(kb[ks].x, kb[ks].y); ww.w = pk2(kb[ks].z, kb[ks].w); Kf[ks] = __builtin_bit_cast(s16x8, ww); }
#pragma unroll
            for (int db = 0; db < 2; ++db)
#pragma unroll
                for (int s2 = 0; s2 < 2; ++s2) Vf[db][s2] = pack8(vx[db][s2]);
        }
        f32x16 S;
#pragma unroll
        for (int i = 0; i < 16; ++i) S[i] = 0.f;
#pragma unroll
        for (int ks = 0; ks < 4; ++ks) S = MFMA32(Kf[ks], Qf[ks], S);
        const int dq = 512 - 32 * t, d0 = dq + r - 8 * hi;
        constexpr float SC = 0.125f * LOG2E;
#define KO_(i) (16 * ((i) >> 3) + 4 * (((i) >> 2) & 1) + ((i) & 3))
        float tmax = -1e30f;
#pragma unroll
        for (int i = 0; i < 16; ++i) { int d = d0 - KO_(i); d = d < -63 ? -63 : (d > 256 ? 256 : d);
            S[i] = S[i] * SC + bl[d + 63]; tmax = fmaxf(tmax, S[i]); }
#undef KO_
        tmax = fmaxf(tmax, __shfl_xor(tmax, 32));
        const float mnew = fmaxf(mrun, tmax), alpha = __builtin_amdgcn_exp2f(mrun - mnew);
        mrun = mnew;
        float ps = 0.f;
#pragma unroll
        for (int i = 0; i < 16; ++i) { S[i] = __builtin_amdgcn_exp2f(S[i] - mnew); ps += S[i]; }
        lsum = lsum * alpha + ps;
#pragma unroll
        for (int db = 0; db < 2; ++db)
#pragma unroll
            for (int i = 0; i < 16; ++i) O[db][i] *= alpha;
#pragma unroll
        for (int s2 = 0; s2 < 2; ++s2) { u32x4 ww; ww.x = pk2(S[8 * s2], S[8 * s2 + 1]); ww.y = pk2(S[8 * s2 + 2], S[8 * s2 + 3]); ww.z = pk2(S[8 * s2 + 4], S[8 * s2 + 5]); ww.w = pk2(S[8 * s2 + 6], S[8 * s2 + 7]);
            const s16x8 pf = __builtin_bit_cast(s16x8, ww);
#pragma unroll
            for (int db = 0; db < 2; ++db) O[db] = MFMA32(Vf[db][s2], pf, O[db]); }
    }
    const float lt = lsum + __shfl_xor(lsum, 32);
    LAS float* po = partO + (size_t)(w * 64 + lane) * 32;
#pragma unroll
    for (int db = 0; db < 2; ++db)
#pragma unroll
        for (int i4 = 0; i4 < 4; ++i4) *(LAS f32x4*)(po + db * 16 + 4 * i4) = (f32x4){O[db][4 * i4], O[db][4 * i4 + 1], O[db][4 * i4 + 2], O[db][4 * i4 + 3]};
    partML[(w * 64 + lane) * 2] = mrun; partML[(w * 64 + lane) * 2 + 1] = lt;
    __syncthreads();
    {
        float mw[8], lw[8], M = -1e30f;
#pragma unroll
        for (int q = 0; q < 8; ++q) { mw[q] = partML[(q * 64 + lane) * 2]; lw[q] = partML[(q * 64 + lane) * 2 + 1]; M = fmaxf(M, mw[q]); }
        float Lt = 0.f; f32x4 o = (f32x4){0.f, 0.f, 0.f, 0.f};
#pragma unroll
        for (int q = 0; q < 8; ++q) { const float sc = __builtin_amdgcn_exp2f(mw[q] - M); Lt += sc * lw[q];
            const f32x4 pv = *(const LAS f32x4*)(partO + (size_t)(q * 64 + lane) * 32 + 4 * w); o += pv * sc; }
        const float inv = __builtin_amdgcn_rcpf(Lt);
        const int db = w >> 2, i4 = w & 3;
        u32x2 ww; ww.x = pk2(o[0] * inv, o[1] * inv); ww.y = pk2(o[2] * inv, o[3] * inv);
        if (st) *(u32x2*)(C.U() + (grow0 + r) * UW + C_QA + h * 64 + 32 * db + 8 * i4 + 4 * hi) = ww;
    }
    __syncthreads();
}
template <bool SAMPLE>
__device__ __forceinline__ void mstate_task(Ctx& C, int l, int unit, int h, int dblk, LAS float* wbuf) {
    constexpr int L = SAMPLE ? 32 : 64, NKS = L / 16;
    const int lane = C.lane, r = lane & 31, hi = lane >> 5;
    const int b = SAMPLE ? unit : unit / NPC, c = SAMPLE ? 0 : unit % NPC;
    const size_t grow0 = SAMPLE ? (size_t)MP + (size_t)unit * TS : (size_t)b * SEQ + (size_t)c * 64;
    const int slot = SAMPLE ? NSLOT_P + unit * 4 + h : unit * 4 + h;
    const bool first = SAMPLE || c == 0;
    const bool valid = lane < L;
    const float li = valid ? C.GATES()[(grow0 + lane) * 8 + h] : -1e30f, lf = valid ? C.GATES()[(grow0 + lane) * 8 + 4 + h] : 0.f;
    const float bc = scan_add(lf, lane), Bc = __shfl(bc, L - 1);
    const float uu = valid ? Bc - bc + li : -1e30f, Mc = wave_max(uu);
    const float w = valid ? fexp(uu - Mc) : 0.f;
    wbuf[lane] = w;
    LDS_WAIT();
    const int d = 32 * dblk + r;
    const bf16* krow = C.KVt() + (size_t)(R_KM + h * 128 + d) * MT + grow0;
    float dn = 0.f; s16x8 Bf[NKS];
    { u32x4 kq[NKS];
#pragma unroll
      for (int ks = 0; ks < NKS; ++ks) kq[ks] = *(const u32x4*)(krow + 16 * ks + 8 * hi);
#pragma unroll
      for (int ks = 0; ks < NKS; ++ks) { const int s0 = 16 * ks + 8 * hi;
        float kc[8]; unpack8(kq[ks], kc);
        const f32x4 w0 = *(const LAS f32x4*)(wbuf + s0), w1 = *(const LAS f32x4*)(wbuf + s0 + 4);
#pragma unroll
        for (int e = 0; e < 8; ++e) { kc[e] *= (e < 4 ? w0[e] : w1[e - 4]); dn += kc[e]; }
        Bf[ks] = pack8(kc); } }
    bf16* dcp = (SAMPLE ? C.DCS() + (size_t)(slot - NSLOT_P) * 16384 : C.DC() + (size_t)slot * 16384);
#pragma unroll
    for (int vb = 0; vb < 4; ++vb) {
        f32x16 acc;
#pragma unroll
        for (int i = 0; i < 16; ++i) acc[i] = 0.f;
        const bf16* vrow = C.KVt() + (size_t)(R_VM + h * 128 + 32 * vb + r) * MT + grow0 + 8 * hi;
        s16x8 af[NKS];
#pragma unroll
        for (int ks = 0; ks < NKS; ++ks) af[ks] = *(const s16x8*)(vrow + 16 * ks);
#pragma unroll
        for (int ks = 0; ks < NKS; ++ks) acc = MFMA32(af[ks], Bf[ks], acc);
#pragma unroll
        for (int i = 0; i < 16; ++i) { const int v = 32 * vb + 8 * (i >> 2) + 4 * hi + (i & 3); dcp[v * 128 + d] = f2bf(acc[i]); }
    }
    dn += __shfl_xor(dn, 32);
    if (hi == 0) C.DN()[(size_t)slot * 128 + d] = dn;
    if (dblk == 0 && lane == 0) { C.MBM()[slot] = Mc; C.MBB()[slot] = Bc; }
    LDS_WAIT();
}


template <bool SAMPLE>
__device__ __forceinline__ void conv_unit(Ctx& C, int l, int unit) {
    constexpr int L = SAMPLE ? 32 : 64;
    const int ch = 2 * C.tid;
    const size_t grow0 = SAMPLE ? (size_t)MP + (size_t)unit * TS : (size_t)unit * 64;
    bf16* up = C.U() + grow0 * UW + C_QM + ch;
    unsigned xr[L];
#pragma unroll
    for (int rr = 0; rr < L; ++rr) xr[rr] = *(const unsigned*)(up + (size_t)rr * UW);
    const float* cw = C.in[15] + (size_t)l * 4096 + ch; const float* cb = C.in[16] + (size_t)l * 1024 + ch;
    const float w0a = cw[0], w0b = cw[1], w1a = cw[1024], w1b = cw[1025], w2a = cw[2048], w2b = cw[2049], w3a = cw[3072], w3b = cw[3073], ba = cb[0], bb = cb[1];
    const float sc = ch >= 512 ? 0.08838834764831845f : 1.f;
    float a0, a1, a2, b0, b1, b2;
    if (SAMPLE) { const float* cl = C.in[4] + ((size_t)(l * NBD + unit) * 3) * 1024 + ch;
        a0 = cl[0]; b0 = cl[1]; a1 = cl[1024]; b1 = cl[1025]; a2 = cl[2048]; b2 = cl[2049];
    } else if ((unit & (NPC - 1)) == 0) { a0 = a1 = a2 = b0 = b1 = b2 = 0.f;
    } else { const bf16* hp = C.HALO() + (size_t)(unit - 1) * 3 * 1024 + ch;
        const unsigned h0 = *(const unsigned*)hp, h1 = *(const unsigned*)(hp + 1024), h2 = *(const unsigned*)(hp + 2048);
        a0 = bflo(h0); b0 = bfhi(h0); a1 = bflo(h1); b1 = bfhi(h1); a2 = bflo(h2); b2 = bfhi(h2); }
    const bool isk = ch >= 512;
    unsigned ta[L / 2], tb2[L / 2];
    float pa = 0.f, pb = 0.f;
#pragma unroll
    for (int rr = 0; rr < L; ++rr) { const float a3 = bflo(xr[rr]), b3 = bfhi(xr[rr]);
        const float va = ba + w0a * a0 + w1a * a1 + w2a * a2 + w3a * a3, vb = bb + w0b * b0 + w1b * b1 + w2b * b2 + w3b * b3;
        const float oa = siluf_(va) * sc, ob = siluf_(vb) * sc;
        *(unsigned*)(up + (size_t)rr * UW) = pk2(oa, ob);
        if (rr & 1) { ta[rr >> 1] = pk2(pa, oa); tb2[rr >> 1] = pk2(pb, ob); } else { pa = oa; pb = ob; }
        a0 = a1; a1 = a2; a2 = a3; b0 = b1; b1 = b2; b2 = b3; }
    if (isk) {
        bf16* kt = C.KVt() + (size_t)(R_KM + ch - 512) * MT + grow0;
#pragma unroll
        for (int q = 0; q < L / 8; ++q) { u32x4 w0; w0.x = ta[4 * q]; w0.y = ta[4 * q + 1]; w0.z = ta[4 * q + 2]; w0.w = ta[4 * q + 3];
            u32x4 w1; w1.x = tb2[4 * q]; w1.y = tb2[4 * q + 1]; w1.z = tb2[4 * q + 2]; w1.w = tb2[4 * q + 3];
            *(u32x4*)(kt + 8 * q) = w0; *(u32x4*)(kt + MT + 8 * q) = w1; }
    }
}
__device__ __forceinline__ void phase_scan(Ctx& C, int l, const bool st, LAS unsigned char* lds) {
    const int gt = C.bid * 512 + C.tid, NT = C.G * 512;
    for (int e = gt; e < 16 * 8192; e += NT) {
        const int chain = e >> 13, p = e & 8191, b = chain >> 2, h = chain & 3;
        const bool hn = p < 128;
        unsigned* base = (unsigned*)C.DC() + p;
        float* dnb = C.DN() + (hn ? p : 0);
        float c0 = 0.f, c1 = 0.f, m = 0.f, nn = 0.f;
        unsigned buf[16], nb[16]; float fb[16], fnb[16];
#pragma unroll
        for (int j = 0; j < 16; ++j) { buf[j] = base[(size_t)((b * NPC + j) * 4 + h) * 8192]; fb[j] = hn ? dnb[(size_t)((b * NPC + j) * 4 + h) * 128] : 0.f; }
        for (int cg0 = 0; cg0 < NPC; cg0 += 16) {
            if (cg0 + 16 < NPC) {
#pragma unroll
                for (int j = 0; j < 16; ++j) { nb[j] = base[(size_t)((b * NPC + cg0 + 16 + j) * 4 + h) * 8192]; fnb[j] = hn ? dnb[(size_t)((b * NPC + cg0 + 16 + j) * 4 + h) * 128] : 0.f; }
            }
#pragma unroll
            for (int j = 0; j < 16; ++j) { const int slot = (b * NPC + cg0 + j) * 4 + h;
                const float Bc = C.MBB()[slot], Mc = C.MBM()[slot];
                const float mn = fmaxf(Bc + m, Mc), g = fexp(Bc + m - mn), f = fexp(Mc - mn);
                if (st) { base[(size_t)slot * 8192] = pk2(c0, c1); if (hn) { dnb[(size_t)slot * 128] = nn; if (p == 0) C.MST()[slot] = m; } }
                c0 = g * c0 + f * bflo(buf[j]); c1 = g * c1 + f * bfhi(buf[j]); nn = g * nn + f * fb[j]; m = mn; }
#pragma unroll
            for (int j = 0; j < 16; ++j) { buf[j] = nb[j]; fb[j] = fnb[j]; }
        }
        const int v = p >> 6, d = (p & 63) * 2;
        float* o = C.out + O_NCP + ((size_t)(l * NBP + b) * 4 + h) * 16384;
        if (st) { o[d * 128 + v] = c0; o[(d + 1) * 128 + v] = c1;
            if (hn) { C.out[O_NNP + ((size_t)(l * NBP + b) * 4 + h) * 128 + p] = nn; if (p == 0) C.out[O_NMP + (size_t)(l * NBP + b) * 4 + h] = m; } }
    }
    LAS float* T = (LAS float*)lds;
    __syncthreads();
    for (int task = C.bid; task < NSLOT_S * 2; task += C.G) {
        const int sl = task >> 1, hf = task & 1, slot = NSLOT_P + sl;
#pragma unroll
        for (int j = 0; j < 2; ++j) { const int q = C.tid + 512 * j, v = q >> 3, d8 = (q & 7) * 8;
            float x[8]; unpack8(*(const u32x4*)(C.DCS() + (size_t)sl * 16384 + v * 128 + 64 * hf + d8), x);
#pragma unroll
            for (int e = 0; e < 8; ++e) T[v * 65 + d8 + e] = x[e]; }
        __syncthreads();
        const float m0 = C.in[7][(size_t)l * NSLOT_S + sl], Bc = C.MBB()[slot], Mc = C.MBM()[slot];
        const float mn = fmaxf(Bc + m0, Mc), g = fexp(Bc + m0 - mn), f = fexp(Mc - mn);
        const float* c0p = C.in[5] + ((size_t)l * NSLOT_S + sl) * 16384 + (size_t)hf * 8192;
        float* op = C.out + O_NCS + ((size_t)l * NSLOT_S + sl) * 16384 + (size_t)hf * 8192;
#pragma unroll 4
        for (int j = 0; j < 16; ++j) { const int il = C.tid + 512 * j, dl = il >> 7, v = il & 127;
            op[il] = g * c0p[il] + f * T[v * 65 + dl]; }
        if (hf == 0 && C.tid < 128) { const float n0 = C.in[6][((size_t)l * NSLOT_S + sl) * 128 + C.tid];
            C.out[O_NNS + ((size_t)l * NSLOT_S + sl) * 128 + C.tid] = g * n0 + f * C.DN()[(size_t)slot * 128 + C.tid];
            if (C.tid == 0) C.out[O_NMS + (size_t)l * NSLOT_S + sl] = mn; }
        __syncthreads();
    }
}

template <bool SAMPLE>
__device__ __forceinline__ void conv8(float (&o)[8], const bf16* U, size_t grow, int ts, int ch0, const LAS float* cwl, const float* cleft) {
    float a[8];
    { const f32x4 b0 = *(const LAS f32x4*)(cwl + 4096 + ch0), b1 = *(const LAS f32x4*)(cwl + 4096 + ch0 + 4);
#pragma unroll
      for (int e = 0; e < 4; ++e) { a[e] = b0[e]; a[4 + e] = b1[e]; } }
#pragma unroll
    for (int j = 0; j < 4; ++j) { const int p = ts - 3 + j, pc = p < 0 ? 0 : p;
        float x[8]; unpack8(*(const u32x4*)(U + (grow - ts + pc) * UW + C_QM + ch0), x);
        if (p < 0) {
#pragma unroll
            for (int e = 0; e < 8; ++e) x[e] = SAMPLE ? cleft[(size_t)(p + 3) * 1024 + ch0 + e] : 0.f;
        }
        const f32x4 w0 = *(const LAS f32x4*)(cwl + j * 1024 + ch0), w1 = *(const LAS f32x4*)(cwl + j * 1024 + ch0 + 4);
#pragma unroll
        for (int e = 0; e < 4; ++e) { a[e] += w0[e] * x[e]; a[4 + e] += w1[e] * x[4 + e]; } }
#pragma unroll
    for (int e = 0; e < 8; ++e) o[e] = siluf_(a[e]);
}
template <bool SAMPLE>
__device__ __forceinline__ void mout_task(Ctx& C, int l, int unit, int h, int tb, const LAS float* cwl, const LAS float* gainl, LAS float* gsbuf, LAS s16x8* qfl, const bool st) {
    constexpr int L = SAMPLE ? 32 : 64;
    const int lane = C.lane, r = lane & 31, hi = lane >> 5;
    const int b = SAMPLE ? unit : unit / NPC, c = SAMPLE ? 0 : unit % NPC;
    const size_t grow0 = SAMPLE ? (size_t)MP + (size_t)unit * TS : (size_t)b * SEQ + (size_t)c * 64;
    const int seq0 = SAMPLE ? 0 : c * 64;
    const int slot = SAMPLE ? NSLOT_P + unit * 4 + h : unit * 4 + h;
    const float* cleft = C.in[4] + ((size_t)(l * NBD + b) * 3) * 1024;
    const bool valid = lane < L;
    const float li = valid ? C.GATES()[(grow0 + lane) * 8 + h] : -1e30f, lf = valid ? C.GATES()[(grow0 + lane) * 8 + 4 + h] : 0.f;
    const float bc = scan_add(lf, lane);
    const float gg = valid ? li - bc : -1e30f;
    const float pmx = scan_max(gg, lane);
    const float m0 = SAMPLE ? C.in[7][(size_t)l * NSLOT_S + unit * 4 + h] : C.MST()[slot];
    const float mt_all = fmaxf(bc + m0, bc + pmx);
    gsbuf[lane] = gg;
    const int tl = 32 * tb + r;
    const float bt = __shfl(bc, tl), mt = __shfl(mt_all, tl);
    const float winter = fexp(bt + m0 - mt);
    const size_t trow = grow0 + tl;
    const float* nvec = SAMPLE ? C.in[6] + ((size_t)l * NSLOT_S + unit * 4 + h) * 128 : C.DN() + (size_t)slot * 128;
    float qn = 0.f;
    { s16x8 tq[8];
      const bf16* qp = C.U() + trow * UW + C_QM + h * 128 + 8 * hi;
#pragma unroll
      for (int ks = 0; ks < 8; ++ks) tq[ks] = *(const s16x8*)(qp + 16 * ks);
      LAS float* nb = (LAS float*)(gsbuf + 64);
      { const float n_a = nvec[lane], n_b = nvec[64 + lane]; nb[lane] = n_a; nb[64 + lane] = n_b; }
#pragma unroll
      for (int ks = 0; ks < 8; ++ks) qfl[ks * 64 + lane] = tq[ks];
      LDS_WAIT();
#pragma unroll 1
      for (int ks = 0; ks < 8; ++ks) { float q8[8]; unpack8(__builtin_bit_cast(u32x4, qfl[ks * 64 + lane]), q8);
        const f32x4 n0 = *(const LAS f32x4*)(nb + 16 * ks + 8 * hi), n1 = *(const LAS f32x4*)(nb + 16 * ks + 8 * hi + 4);
#pragma unroll
        for (int e = 0; e < 4; ++e) qn += q8[e] * n0[e] + q8[4 + e] * n1[e]; } }
    qn += __shfl_xor(qn, 32);
    LDS_WAIT();
    f32x16 acc[4];
#pragma unroll
    for (int vb = 0; vb < 4; ++vb)
#pragma unroll
        for (int i = 0; i < 16; ++i) acc[vb][i] = 0.f;
    if (SAMPLE) {
        const float* cp = C.in[5] + ((size_t)l * NSLOT_S + unit * 4 + h) * 16384 + r;
#pragma unroll 1
        for (int ks = 0; ks < 8; ++ks) { const s16x8 qv = qfl[ks * 64 + lane];
#pragma unroll
            for (int vb = 0; vb < 4; ++vb) { float x[8];
#pragma unroll
                for (int e = 0; e < 8; ++e) x[e] = cp[(size_t)(16 * ks + 8 * hi + e) * 128 + 32 * vb];
                acc[vb] = MFMA32(pack8(x), qv, acc[vb]); } }
    } else {
        const bf16* cp = C.DC() + (size_t)slot * 16384 + (size_t)r * 128 + 8 * hi;
#pragma unroll 1
        for (int ks = 0; ks < 8; ++ks) { const s16x8 qv = qfl[ks * 64 + lane];
#pragma unroll
            for (int vb = 0; vb < 4; ++vb) acc[vb] = MFMA32(*(const s16x8*)(cp + (size_t)vb * 4096 + 16 * ks), qv, acc[vb]); }
    }
#pragma unroll
    for (int vb = 0; vb < 4; ++vb)
#pragma unroll
        for (int i = 0; i < 16; ++i) acc[vb][i] *= winter;
    float den = 0.f;
    const int nsb = SAMPLE ? 1 : tb + 1;
#pragma unroll 1
    for (int sb = 0; sb < nsb; ++sb) {
        f32x16 S;
#pragma unroll
        for (int i = 0; i < 16; ++i) S[i] = 0.f;
        const int sl = 32 * sb + r;
        { s16x8 tk[8];
          const bf16* kp = C.U() + (grow0 + sl) * UW + C_KM + h * 128 + 8 * hi;
#pragma unroll
          for (int ks = 0; ks < 8; ++ks) tk[ks] = *(const s16x8*)(kp + 16 * ks);
#pragma unroll
          for (int ks = 0; ks < 8; ++ks) S = MFMA32(tk[ks], qfl[ks * 64 + lane], S); }
        const float e0 = (bt - mt) * LOG2E;
#pragma unroll
        for (int i4 = 0; i4 < 4; ++i4) { const f32x4 gs = *(const LAS f32x4*)(gsbuf + 32 * sb + 8 * i4 + 4 * hi);
#pragma unroll
            for (int e = 0; e < 4; ++e) { const int sidx = 32 * sb + 8 * i4 + 4 * hi + e;
                const float wv = (sidx <= tl) ? __builtin_amdgcn_exp2f(e0 + gs[e] * LOG2E) : 0.f;
                S[4 * i4 + e] *= wv; den += S[4 * i4 + e]; } }
#pragma unroll
        for (int s2 = 0; s2 < 2; ++s2) { u32x4 w; w.x = pk2(S[8 * s2], S[8 * s2 + 1]); w.y = pk2(S[8 * s2 + 2], S[8 * s2 + 3]); w.z = pk2(S[8 * s2 + 4], S[8 * s2 + 5]); w.w = pk2(S[8 * s2 + 6], S[8 * s2 + 7]);
            const s16x8 pf = __builtin_bit_cast(s16x8, w);
            const bf16* vp0 = C.KVt() + (size_t)(R_VM + h * 128 + r) * MT + grow0 + 32 * sb + 16 * s2 + 4 * hi;
#pragma unroll
            for (int vb = 0; vb < 4; ++vb) { const bf16* vp = vp0 + (size_t)(32 * vb) * MT;
                const u32x2 a = *(const u32x2*)vp, bq = *(const u32x2*)(vp + 8); u32x4 vw; vw.x = a.x; vw.y = a.y; vw.z = bq.x; vw.w = bq.y;
                acc[vb] = MFMA32(__builtin_bit_cast(s16x8, vw), pf, acc[vb]); } }
    }
    den += __shfl_xor(den, 32);
    den += winter * qn;
    const float inv = __builtin_amdgcn_rcpf(fmaxf(fabsf(den), fexp(-mt)));
    float ss = 0.f;
#pragma unroll
    for (int vb = 0; vb < 4; ++vb)
#pragma unroll
        for (int i = 0; i < 16; ++i) { acc[vb][i] *= inv; ss += acc[vb][i] * acc[vb][i]; }
    ss += __shfl_xor(ss, 32);
    const float rn = rsqrtf(ss * (1.f / 128.f) + EPS);
    int lane2 = lane; asm volatile("" : "+v"(lane2));
    const int hi2 = lane2 >> 5;
    bf16* orow = C.U() + (grow0 + 32 * tb + (lane2 & 31)) * UW + C_OM + h * 128;
#pragma unroll
    for (int vb = 0; vb < 4; ++vb)
#pragma unroll
        for (int i4 = 0; i4 < 4; ++i4) { const int v0 = 32 * vb + 8 * i4 + 4 * hi2;
            const u32x2 ow = *(const u32x2*)(orow + v0); const f32x4 gn = *(const LAS f32x4*)(gainl + h * 128 + v0);
            const float y0 = acc[vb][4 * i4] * rn * gn[0] * sigmoidf_(bflo(ow.x)), y1 = acc[vb][4 * i4 + 1] * rn * gn[1] * sigmoidf_(bfhi(ow.x));
            const float y2 = acc[vb][4 * i4 + 2] * rn * gn[2] * sigmoidf_(bflo(ow.y)), y3 = acc[vb][4 * i4 + 3] * rn * gn[3] * sigmoidf_(bfhi(ow.y));
            u32x2 w; w.x = pk2(y0, y1); w.y = pk2(y2, y3); if (st) *(u32x2*)(orow + v0) = w; if (i4 == 3) asm volatile("" ::: "memory"); }
    LDS_WAIT();
}


template <class F>
__device__ __forceinline__ void mini_gemm(Ctx& C, const bf16* A, int lda, const bf16* Bt, int K, LAS unsigned char* lds, const F& epi) {
    const int lane = C.lane, r = lane & 31, hi = lane >> 5, w = C.wave, sm = w & 1, sn = (w >> 1) & 1, kh = w >> 2;
    LAS float* red = (LAS float*)lds + (w & 3) * 1024;
    for (int tile = C.bid; tile < 256; tile += C.G) {
        const int tm = tile >> 4, tn = tile & 15;
        const int row0 = MP + 64 * tm + 32 * sm, col0 = 64 * tn + 32 * sn, kh0 = kh * (K >> 1);
        const bf16* pa = A + (size_t)(row0 + r) * lda + kh0 + 8 * hi;
        const bf16* pb = Bt + (size_t)(col0 + r) * K + kh0 + 8 * hi;
        f32x16 acc;
#pragma unroll
        for (int i = 0; i < 16; ++i) acc[i] = 0.f;
#pragma unroll 16
        for (int k = 0; k < (K >> 1); k += 16) acc = MFMA32(*(const s16x8*)(pa + k), *(const s16x8*)(pb + k), acc);
        if (kh == 1) {
#pragma unroll
            for (int i = 0; i < 16; ++i) red[i * 64 + lane] = acc[i];
        }
        __syncthreads();
        if (kh == 0) {
            f32x2_t pre[16];
#pragma unroll
            for (int i = 0; i < 16; ++i) pre[i] = epi.pre(row0 + 8 * (i >> 2) + 4 * hi + (i & 3), col0 + r);
#pragma unroll
            for (int i = 0; i < 16; ++i) { const float v = acc[i] + red[i * 64 + lane];
                epi.fin(row0 + 8 * (i >> 2) + 4 * hi + (i & 3), col0 + r, v, pre[i]); }
        }
        __syncthreads();
    }
}

struct MiniGate {
    bf16* U; int cgate; int cadd; bool st;
    __device__ __forceinline__ f32x2_t pre(int rr, int cc) const { const bf16* p = U + (size_t)rr * UW + cc; f32x2_t o; o.x = bf1(p[cgate]); o.y = cadd >= 0 ? bf1(p[cadd]) : 0.f; return o; }
    __device__ __forceinline__ void fin(int rr, int cc, float v, f32x2_t p) const { if (st) U[(size_t)rr * UW + cgate + cc] = f2bf(p.y + sigmoidf_(p.x) * v); }
};
struct MiniRes {
    const float* xs; float* X; const float* gt; bool st;
    __device__ __forceinline__ f32x2_t pre(int rr, int cc) const { const int rs = rr - MP; f32x2_t o; o.x = xs[(size_t)rs * DM + cc]; o.y = gt[(size_t)(4 + (rs >> 5)) * 6144 + cc]; return o; }
    __device__ __forceinline__ void fin(int rr, int cc, float v, f32x2_t p) const { if (st) X[(size_t)rr * DM + cc] = p.x + p.y * v; }
};
constexpr int LDS_BYTES = 131072 + 2048;
__global__ void __launch_bounds__(512) fwd_megakernel(Args args) {
    extern __shared__ __attribute__((aligned(16))) unsigned char lds_raw[];
    LAS unsigned char* lds = (LAS unsigned char*)lds_raw;
    cg::grid_group grid = cg::this_grid();
    Ctx C;
    C.in = args.in; C.out = args.out; C.ws = args.ws;
    volatile LAS unsigned* bst = (volatile LAS unsigned*)(lds + 131072 + 1024);
    if (threadIdx.x < 2) bst[threadIdx.x] = 0u;
    __syncthreads();
    (void)xcd_barrier_post((unsigned*)(args.ws + WS_CTL), bst);
    C.tid = threadIdx.x; C.lane = C.tid & 63; C.wave = __builtin_amdgcn_readfirstlane(C.tid >> 6); C.G = gridDim.x; C.bid = blockIdx.x;
    float* X = C.out;
#define PHASE_BEGIN() do { int t_ = C.tid; asm volatile("" : "+v"(t_)); C.tid = t_; C.lane = t_ & 63; C.wave = __builtin_amdgcn_readfirstlane(t_ >> 6); \
        int g_ = C.G, b_ = C.bid; asm volatile("" : "+s"(g_), "+s"(b_)); C.G = g_; C.bid = b_; } while (0)

#define GSYNC() do { XcdBarrier xb_; xb_.bar = (unsigned*)(C.ws + WS_CTL); xb_.x = xb_xcc_id(); xb_.st = (volatile LAS unsigned*)(lds + 131072 + 1024); xcd_barrier(xb_); } while (0)
    for (int l = 0; l < 2; ++l) {
        PHASE_BEGIN();
        if (l == 0) {
            for (int rep = 0; rep < REP_MISC; ++rep) { phase_convert(C, 0, lds, 0, CV_ALL, 2); __syncthreads(); PHASE_BEGIN(); }
            if (C.ws == nullptr) grid.sync();
            GSYNC();
            PHASE_BEGIN();
        }
        if (l == 1) { phase_convert(C, 1, lds, CV_SPLIT, CV_ALL, 0); PHASE_BEGIN(); }
        for (int rep = 0; rep < REP_MISC; ++rep) { phase_norm<true, false>(C, l, l == 0 ? C.in[0] : nullptr, C.in[1], C.in[12] + l * 1024, 0, 1, lds); __syncthreads(); PHASE_BEGIN(); }
        GSYNC(); PHASE_BEGIN();
        {
            pg8::Gemm g{1024, 1024, 1024}; pg8::Sched S;
            S.init(C.XN(), C.W() + W_IN, MT, UW, C.W() + W_IN + (size_t)UW * 1024 * 2, C.XN(), 1024, MT, 1024, 1024, C.G, C.bid);
            pg8::EpiIn E{C.U(), C.KVt(), C.HALO()};
            for (int rep = 0; rep < REP_GEMM; ++rep) { pg8::gemm_phase(lds, g, S, E, C.tid); PHASE_BEGIN(); }
        }
        GSYNC(); PHASE_BEGIN();
        {
            LAS float* biasl = (LAS float*)lds;
            LAS float* wb = (LAS float*)(lds + 16384) + C.wave * 64;
            LAS s16x8* qfa = (LAS s16x8*)(lds + 32768) + C.wave * 512;
            for (int i = C.tid; i < 8 * 320; i += 512) biasl[i] = C.in[17][(size_t)l * 8 * 320 + i] * LOG2E;
            __syncthreads();
            constexpr int NA_S = NBD, NA_P = NBP * NPC, NM_S = NBD * 2, NM_P = NBP * NPC * 2;
            for (int rep = 0; rep < REP_P3; ++rep) { const bool st = (rep == REP_P3 - 1) || (C.ws == nullptr);
            for (int u = C.bid; u < NBD * 8; u += C.G) { PHASE_BEGIN(); attn_sample_wg(C, l, u >> 3, u & 7, biasl, (LAS float*)(lds + 32768), (LAS float*)(lds + 98304), st); }
            if (C.G == 256) {
                for (int i = 0; i < 2; ++i) { PHASE_BEGIN(); attn_task<false>(C, l, (C.bid & 7) * 64 + i * 32 + (C.bid >> 3), C.wave, biasl, qfa, st); }
            } else {
                for (int u = C.bid; u < NA_P; u += C.G) { PHASE_BEGIN(); attn_task<false>(C, l, u, C.wave, biasl, qfa, st); }
            }
            if (rep == REP_P3 - 1) {
                for (int u = C.bid; u < NBD + NBP * NPC; u += C.G) { PHASE_BEGIN(); if (u < NBD) conv_unit<true>(C, l, u); else conv_unit<false>(C, l, u - NBD); }
            }
            }
            PHASE_BEGIN();
            for (int rep = 0; rep < REP_COPY; ++rep) {
            const int gt = C.bid * 512 + C.tid, NT = C.G * 512;
            for (int e = gt; e < NBP * 512 * 512; e += NT) { const int b = e >> 18, t = (e >> 9) & 511, cc = e & 511; const size_t row = (size_t)b * SEQ + 7680 + t;
                C.out[O_NKP + (size_t)l * NBP * 262144 + e] = bf1(C.U()[row * UW + C_KA + cc]); }
            {
                LAS float* T = (LAS float*)(lds + 32768);
                __syncthreads();
                for (int tile = C.bid; tile < NBP * 64; tile += C.G) {
                    const int b = tile >> 6, tb = (tile >> 3) & 7, cb8 = tile & 7;
                    { const int ccl = C.tid >> 3, t8 = (C.tid & 7) * 8; const size_t row = (size_t)b * SEQ + 7680 + tb * 64 + t8;
                      float x[8]; unpack8(*(const u32x4*)(C.KVt() + (size_t)(R_VA + cb8 * 64 + ccl) * MT + row), x);
#pragma unroll
                      for (int e = 0; e < 8; ++e) T[ccl * 65 + t8 + e] = x[e]; }
                    __syncthreads();
                    { const int tl = C.tid >> 3, c8 = (C.tid & 7) * 8;
                      float* o = C.out + O_NVP + (size_t)l * NBP * 262144 + ((size_t)b * 512 + tb * 64 + tl) * 512 + cb8 * 64 + c8;
                      f32x4 a, c;
                      a.x = T[(c8 + 0) * 65 + tl]; a.y = T[(c8 + 1) * 65 + tl]; a.z = T[(c8 + 2) * 65 + tl]; a.w = T[(c8 + 3) * 65 + tl];
                      c.x = T[(c8 + 4) * 65 + tl]; c.y = T[(c8 + 5) * 65 + tl]; c.z = T[(c8 + 6) * 65 + tl]; c.w = T[(c8 + 7) * 65 + tl];
                      *(f32x4*)o = a; *(f32x4*)(o + 4) = c; }
                    __syncthreads();
                }
            }
            for (int e = gt; e < NBD * TS * 512; e += NT) { const int bd = e >> 14, t = (e >> 9) & 31, cc = e & 511; const size_t row = (size_t)MP + bd * TS + t;
                C.out[O_NKS + (size_t)l * NBD * TS * 512 + e] = bf1(C.U()[row * UW + C_KA + cc]); }
            {
                LAS float* T = (LAS float*)(lds + 32768);
                for (int tile = C.bid; tile < NBD * 8; tile += C.G) {
                    const int bd = tile >> 3, cb8 = tile & 7;
                    { const int ccl = C.tid >> 3, t4 = (C.tid & 7) * 4; const size_t row = (size_t)MP + bd * TS + t4;
                      const u32x2 v = *(const u32x2*)(C.KVt() + (size_t)(R_VA + cb8 * 64 + ccl) * MT + row);
                      T[ccl * 33 + t4] = bflo(v.x); T[ccl * 33 + t4 + 1] = bfhi(v.x); T[ccl * 33 + t4 + 2] = bflo(v.y); T[ccl * 33 + t4 + 3] = bfhi(v.y); }
                    __syncthreads();
                    { const int tl = C.tid >> 4, c4 = (C.tid & 15) * 4;
                      f32x4 a; a.x = T[(c4 + 0) * 33 + tl]; a.y = T[(c4 + 1) * 33 + tl]; a.z = T[(c4 + 2) * 33 + tl]; a.w = T[(c4 + 3) * 33 + tl];
                      *(f32x4*)(C.out + O_NVS + (size_t)l * NBD * TS * 512 + ((size_t)bd * TS + tl) * 512 + cb8 * 64 + c4) = a; }
                    __syncthreads();
                }
            }
            for (int e = gt; e < NBP * 3 * 1024; e += NT) { const int b = e / 3072, j = (e / 1024) % 3, ch = e & 1023;
                C.out[O_NCVP + (size_t)l * NBP * 3072 + e] = bf1(C.HALO()[((size_t)(b * NPC + NPC - 1) * 3 + j) * 1024 + ch]); }
            for (int e = gt; e < NBD * 3 * 1024; e += NT) { const int bd = e / 3072, j = (e / 1024) % 3, ch = e & 1023;
                C.out[O_NCVS + (size_t)l * NBD * 3072 + e] = bf1(C.HALO()[((size_t)(512 + bd) * 3 + j) * 1024 + ch]); }
            PHASE_BEGIN(); }
        }
        GSYNC(); PHASE_BEGIN();
        {
            LAS float* wb = (LAS float*)(lds + 16384) + C.wave * 64;
            constexpr int NM_S = NBD * 2, NM_P = NBP * NPC * 2;
            for (int u = C.bid; u < NM_S + NM_P; u += C.G) {
                PHASE_BEGIN();
                if (u < NM_S) mstate_task<true>(C, l, u >> 1, 2 * (u & 1) + (C.wave >> 2), C.wave & 3, wb);
                else { const int v = u - NM_S; mstate_task<false>(C, l, v >> 1, 2 * (v & 1) + (C.wave >> 2), C.wave & 3, wb); }
            }
        }
        GSYNC(); PHASE_BEGIN();
        for (int rep = 0; rep < REP_SYNC; ++rep) GSYNC();
        for (int rep = 0; rep < REP_SCAN; ++rep) { phase_scan(C, l, (rep == REP_SCAN - 1) || (C.ws == nullptr), lds); PHASE_BEGIN(); }
        GSYNC(); PHASE_BEGIN();
        {
            LAS float* cwl = (LAS float*)lds;
            LAS float* gainl = cwl + 5 * 1024;
            LAS float* gsb = gainl + 512 + C.wave * 192;
            LAS s16x8* qfl = (LAS s16x8*)(lds + 32768) + C.wave * 512;
            for (int i = C.tid; i < 4096; i += 512) cwl[i] = C.in[15][(size_t)l * 4096 + i];
            for (int i = C.tid; i < 1024; i += 512) cwl[4096 + i] = C.in[16][(size_t)l * 1024 + i];
            gainl[C.tid] = C.in[18][(size_t)l * 512 + C.tid];
            __syncthreads();
            constexpr int NU_S = NBD * 4 / 8, NU_P = NBP * NPC;
            for (int rep = 0; rep < REP_MOUT; ++rep) { const bool st = (rep == REP_MOUT - 1) || (C.ws == nullptr);
            for (int u = C.bid, it = 0; u < NU_P; u += C.G, ++it) {
                PHASE_BEGIN();
                mout_task<false>(C, l, u, C.wave >> 1, C.wave & 1, cwl, gainl, gsb, qfl, st);
                if (it == 0 && C.wave == 0 && C.bid < NBD * 4) mout_task<true>(C, l, C.bid >> 2, C.bid & 3, 0, cwl, gainl, gsb, qfl, st);
            }
            }
        }
        GSYNC(); PHASE_BEGIN();
        {
            pg8::Gemm g{UW, 512, 512}; pg8::Sched S;
            S.init(C.U() + C_QA, C.W() + W_BA, MT, 1024, nullptr, nullptr, 0, 0, UW, 512, C.G, C.bid);
            for (int rep = 0; rep < REP_N1024; ++rep) { const bool st = (rep == REP_N1024 - 1) || (C.ws == nullptr);
            S.init(C.U() + C_QA, C.W() + W_BA, MP, 1024, nullptr, nullptr, 0, 0, UW, 512, C.G, C.bid);
            pg8::EpiGate E{C.U() + C_GA, nullptr, C.U() + C_GA, st};
            pg8::gemm_phase(lds, g, S, E, C.tid);
            { MiniGate mg{C.U(), C_GA, -1, st}; mini_gemm(C, C.U() + C_QA, UW, (const bf16*)(C.W() + W_BA), 512, lds, mg); }
            __threadfence(); __syncthreads(); PHASE_BEGIN();
            S.init(C.U() + C_OM, C.W() + W_BM, MP, 1024, nullptr, nullptr, 0, 0, UW, 512, C.G, C.bid);
            pg8::EpiGate E2{C.U() + C_GM, C.U() + C_GA, C.U() + C_GM, st};
            pg8::gemm_phase(lds, g, S, E2, C.tid);
            { MiniGate mg{C.U(), C_GM, C_GA, st}; mini_gemm(C, C.U() + C_OM, UW, (const bf16*)(C.W() + W_BM), 512, lds, mg); }
            PHASE_BEGIN(); }
        }
        GSYNC(); PHASE_BEGIN();
        {
            pg8::Gemm g{UW, 1024, 1024}; pg8::Sched S;
            S.init(C.U() + C_GM, C.W() + W_OUT, MP, 1024, nullptr, nullptr, 0, 0, UW, 1024, C.G, C.bid);
            for (int rep = 0; rep < REP_N1024; ++rep) { const bool st = (rep == REP_N1024 - 1) || (C.ws == nullptr);
            pg8::EpiRes E{l == 0 ? C.in[0] : nullptr, C.in[1], X, C.MOD(l) + 2 * 1024, st};
            pg8::gemm_phase(lds, g, S, E, C.tid);
            { MiniRes mr{l == 0 ? C.in[1] : X + (size_t)MP * DM, X, C.MOD(l) + 2 * 1024, st}; mini_gemm(C, C.U() + C_GM, UW, (const bf16*)(C.W() + W_OUT), 1024, lds, mr); }
            PHASE_BEGIN(); }
        }
        GSYNC(); PHASE_BEGIN();
        if (l == 0) { phase_convert(C, 1, lds, 0, CV_SPLIT, 0); PHASE_BEGIN(); }
        for (int rep = 0; rep < REP_MISC; ++rep) { phase_norm<false, false>(C, l, nullptr, nullptr, C.in[22] + l * 1024, 3, 4, lds); __syncthreads(); PHASE_BEGIN(); }
        GSYNC(); PHASE_BEGIN();
        {
            pg8::Gemm g{1024, 1024, 1024}; pg8::Sched S;
            S.init(C.XN(), C.W() + W_GU, MT, 2 * DFF, nullptr, nullptr, 0, 0, 1024, 1024, C.G, C.bid);
            pg8::EpiSwiglu E{C.ACT()};
            for (int rep = 0; rep < REP_GEMM; ++rep) { pg8::gemm_phase(lds, g, S, E, C.tid); PHASE_BEGIN(); }
        }
        GSYNC(); PHASE_BEGIN();
        {
            pg8::Gemm g{DFF, DFF, DFF}; pg8::Sched S;
            S.init(C.ACT(), C.W() + W_DN, MP, 1024, nullptr, nullptr, 0, 0, DFF, DFF, C.G, C.bid);
            for (int rep = 0; rep < REP_N1024; ++rep) { const bool st = (rep == REP_N1024 - 1) || (C.ws == nullptr);
            pg8::EpiRes E{nullptr, nullptr, X, C.MOD(l) + 5 * 1024, st};
            pg8::gemm_phase(lds, g, S, E, C.tid);
            { MiniRes mr{X + (size_t)MP * DM, X, C.MOD(l) + 5 * 1024, st}; mini_gemm(C, C.ACT(), DFF, (const bf16*)(C.W() + W_DN), DFF, lds, mr); }
            PHASE_BEGIN(); }
        }
        GSYNC(); PHASE_BEGIN();
    }
    phase_norm<false, true>(C, 0, nullptr, nullptr, C.in[25], 0, 0, lds);
}

extern "C" void kernel_launch(void* const* d_in, const int* in_sizes, int n_in, void* d_out, int out_size, void* d_ws, size_t ws_size, hipStream_t stream) {
    static int grid = 0;
    if (grid == 0) {
        if (n_in != 26 || (size_t)out_size != O_END || ws_size < WS_CTL + CTL_BYTES) { fprintf(stderr, "kernel_launch: unexpected shapes (n_in %d out %d ws %zu)\n", n_in, out_size, ws_size); grid = -1; return; }
        int dev = 0, cus = 0, per_cu = 0;
        hipGetDevice(&dev); hipDeviceGetAttribute(&cus, hipDeviceAttributeMultiprocessorCount, dev);
        hipFuncSetAttribute((const void*)fwd_megakernel, hipFuncAttributeMaxDynamicSharedMemorySize, LDS_BYTES);
        hipOccupancyMaxActiveBlocksPerMultiprocessor(&per_cu, (const void*)fwd_megakernel, 512, LDS_BYTES);
        (void)hipGetLastError();
        if (per_cu < 1) per_cu = 1;
        grid = cus * 1;
    }
    if (grid < 0) return;
    Args a{};
    for (int i = 0; i < 26; ++i) a.in[i] = (const float*)d_in[i];
    a.out = (float*)d_out; a.ws = (unsigned char*)d_ws;
    if (hipMemsetAsync((char*)d_ws + WS_CTL, 0, CTL_BYTES, stream) != hipSuccess) { fprintf(stderr, "memset failed\n"); return; }
    void* kargs[] = {&a};
    hipError_t e = hipLaunchCooperativeKernel((const void*)fwd_megakernel, dim3(grid), dim3(512), kargs, LDS_BYTES, stream);
    if (e != hipSuccess) fprintf(stderr, "cooperative launch failed: %s (grid %d)\n", hipGetErrorString(e), grid);
}
```
